# Optimizing an MI355X kernel written in HIP

```python
import math
import jax, jax.numpy as jnp
from jax import lax
import numpy as np

D_MODEL = 2048
BATCH = 2
SEQ = 4096
DEPTH = 1

REC_HEAD_DIM = 128
REC_HEADS = D_MODEL // 256
D_REC = REC_HEADS * REC_HEAD_DIM
REC_CHUNK = 64
ATT_HEAD_DIM = 128
ATT_HEADS_PER_GROUP = D_MODEL // 512
DIL_GROUPS = ((128, 1), (512, 4), (2048, 16))
N_GROUPS = 3
ATT_HEADS = N_GROUPS * ATT_HEADS_PER_GROUP
D_ATT = ATT_HEADS * ATT_HEAD_DIM
D_ATT_OUT = ATT_HEADS_PER_GROUP * ATT_HEAD_DIM
ATT_BLOCK = 64
NUM_BUCKETS = 32
MAX_DISTANCE = 1024
N_EXPERTS = 32
TOP_K = 4
D_FF = D_MODEL
SWIGLU_LIMIT = 7.0
SWIGLU_ALPHA = 1.702
EXPERT_BLOCK = 128
RMS_EPS = 1e-6
NEG_INF = -1e30
IN_WIDTHS = (D_REC, D_REC, D_REC, D_REC, D_REC, D_ATT, D_ATT, D_ATT, D_MODEL, D_MODEL)
D_IN = 5 * D_REC + 3 * D_ATT + 2 * D_MODEL

kernel_name = 'hybrid_hgrn2_dilated_attn_moe_block'


def rms_norm(x, g):
    xf = x.astype(jnp.float32)
    y = xf * lax.rsqrt(jnp.mean(xf * xf, axis=-1, keepdims=True) + RMS_EPS)
    return (y * g.astype(jnp.float32)).astype(x.dtype)


def modulate(h, shift, scale):
    return h * (1 + scale) + shift


def gla_scan(q, k, v, logf):
    Bn, S, H, Dk = q.shape
    Dv = v.shape[-1]
    n_chunks = S // REC_CHUNK

    def chunks(t):
        return t.reshape(Bn, n_chunks, REC_CHUNK, H, t.shape[-1]).transpose(1, 0, 3, 2, 4)

    tril = jnp.tril(jnp.ones((REC_CHUNK, REC_CHUNK), dtype=bool))[..., None]

    def step(state, inp):
        qc, kc, vc, gc = inp
        b = jnp.cumsum(gc, axis=2)
        b_last = b[:, :, -1:, :]
        diff = b[:, :, :, None, :] - b[:, :, None, :, :]
        decay = jnp.where(tril, jnp.exp(jnp.where(tril, diff, 0.0)), 0.0)
        scores = jnp.einsum('bhid,bhijd,bhjd->bhij', qc, decay, kc)
        o = (jnp.einsum('bhij,bhjv->bhiv', scores, vc)
             + jnp.einsum('bhid,bhdv->bhiv', qc * jnp.exp(b), state))
        state = (jnp.exp(b_last)[:, :, 0, :, None] * state
                 + jnp.einsum('bhcd,bhcv->bhdv', kc * jnp.exp(b_last - b), vc))
        return state, o

    state0 = jnp.zeros((Bn, H, Dk, Dv), jnp.float32)
    _, o = lax.scan(step, state0, (chunks(q), chunks(k), chunks(v), chunks(logf)))
    return o.transpose(1, 0, 3, 2, 4).reshape(Bn, S, H, Dv)


def hgrn2_branch(q_in, i_in, zf_fwd, zf_bwd, z_out, lb, g_out):
    Bn, S, _ = q_in.shape

    def heads(t):
        return t.astype(jnp.float32).reshape(Bn, S, REC_HEADS, REC_HEAD_DIM)

    q = heads(jax.nn.silu(q_in.astype(jnp.float32)))
    v = heads(i_in)

    def gates(z, lbd):
        f = lbd + (1.0 - lbd) * jax.nn.sigmoid(z.astype(jnp.float32))
        return heads(1.0 - f), heads(jnp.log(f))

    k_f, lf_f = gates(zf_fwd, lb[0])
    k_b, lf_b = gates(zf_bwd, lb[1])

    def flip(t):
        return jnp.flip(t, axis=1)

    o = gla_scan(q, k_f, v, lf_f) + flip(gla_scan(flip(q), flip(k_b), flip(v), flip(lf_b)))
    o = o * lax.rsqrt(jnp.mean(o * o, axis=-1, keepdims=True) + RMS_EPS)
    o = o.reshape(Bn, S, D_REC) * g_out.astype(jnp.float32) * jax.nn.sigmoid(z_out.astype(jnp.float32))
    return o.astype(q_in.dtype)


def t5_bucket(rel):
    half_buckets = NUM_BUCKETS // 2
    ret = jnp.where(rel > 0, half_buckets, 0)
    n = jnp.abs(rel)
    max_exact = half_buckets // 2
    nf = jnp.maximum(n, 1).astype(jnp.float32)
    large = max_exact + (jnp.log(nf / max_exact) / math.log(MAX_DISTANCE / max_exact)
                         * (half_buckets - max_exact)).astype(jnp.int32)
    large = jnp.minimum(large, half_buckets - 1)
    return ret + jnp.where(n < max_exact, n, large)


def dilated_group(q, k, v, bias_table, window, dil):
    Bn, S, H, Dh = q.shape
    half = window // (2 * dil)
    L = S // dil
    nb = -(-L // ATT_BLOCK)
    Lp = nb * ATT_BLOCK

    def to_sub(t):
        return t.reshape(Bn, L, dil, H, Dh).transpose(0, 2, 3, 1, 4)

    def pad(t, lo, hi):
        return jnp.pad(t, ((0, 0), (0, 0), (0, 0), (lo, hi), (0, 0)))

    qb = pad(to_sub(q), 0, Lp - L).reshape(Bn, dil, H, nb, ATT_BLOCK, Dh)

    def band(t):
        tp = pad(to_sub(t), ATT_BLOCK, Lp - L + ATT_BLOCK).reshape(Bn, dil, H, nb + 2, ATT_BLOCK, Dh)
        return jnp.concatenate([tp[:, :, :, :-2], tp[:, :, :, 1:-1], tp[:, :, :, 2:]], axis=4)

    kb, vb = band(k), band(v)
    s = jnp.einsum('bdhnqe,bdhnke->bdhnqk', qb, kb,
                   preferred_element_type=jnp.float32) * (Dh ** -0.5)
    q_off = jnp.arange(ATT_BLOCK)[:, None]
    rel = jnp.arange(3 * ATT_BLOCK)[None, :] - ATT_BLOCK - q_off
    bias = bias_table[t5_bucket(rel * dil)].transpose(2, 0, 1).astype(jnp.float32)
    k_idx = (jnp.arange(nb) * ATT_BLOCK)[:, None, None] + q_off[None] + rel[None]
    valid = (jnp.abs(rel) <= half)[None] & (k_idx >= 0) & (k_idx < L)
    s = jnp.where(valid, s + bias[:, None], NEG_INF)
    m = jnp.max(s, axis=-1)
    p = jnp.exp(s - m[..., None])
    l = jnp.sum(p, axis=-1)
    num = jnp.einsum('bdhnqk,bdhnke->bdhnqe', p, vb.astype(jnp.float32))

    def from_sub(t):
        t = t.reshape((Bn, dil, H, Lp) + t.shape[5:])[:, :, :, :L]
        t = jnp.moveaxis(t, 3, 1)
        return t.reshape((Bn, S, H) + t.shape[4:])

    return from_sub(num), from_sub(m), from_sub(l)


def dilated_attention(q_in, k_in, v_in, rel_bias):
    Bn, S, _ = q_in.shape

    def heads(t):
        return t.reshape(Bn, S, ATT_HEADS, ATT_HEAD_DIM)

    q, k, v = heads(q_in), heads(k_in), heads(v_in)
    nums, ms, ls = [], [], []
    for g, (window, dil) in enumerate(DIL_GROUPS):
        hs = slice(g * ATT_HEADS_PER_GROUP, (g + 1) * ATT_HEADS_PER_GROUP)
        num, m, l = dilated_group(q[:, :, hs], k[:, :, hs], v[:, :, hs], rel_bias[:, hs], window, dil)
        nums.append(num)
        ms.append(m)
        ls.append(l)
    m_all = jnp.stack(ms)
    w = jnp.exp(m_all - jnp.max(m_all, axis=0))
    num = jnp.sum(w[..., None] * jnp.stack(nums), axis=0)
    den = jnp.sum(w * jnp.stack(ls), axis=0)
    out = num / den[..., None]
    return out.reshape(Bn, S, D_ATT_OUT).astype(q_in.dtype)


def hybrid_mixer(h, w_in, lb, g_rec_out, rel_bias, w_branch_rec, w_branch_att, w_o):
    splits = np.cumsum(IN_WIDTHS)[:-1].tolist()
    proj = h @ w_in
    q_r, i_r, zf_f, zf_b, z_o, q_a, k_a, v_a, zg_rec, zg_att = jnp.split(proj, splits, axis=-1)
    y_rec = hgrn2_branch(q_r, i_r, zf_f, zf_b, z_o, lb, g_rec_out) @ w_branch_rec
    y_att = dilated_attention(q_a, k_a, v_a, rel_bias) @ w_branch_att
    merged = jax.nn.sigmoid(zg_rec) * y_rec + jax.nn.sigmoid(zg_att) * y_att
    return merged @ w_o


def moe_ffn(h, w_router, b_router, w_gate_up, b_gate_up, w_down, b_down):
    Bn, S, D = h.shape
    T = Bn * S
    hf = h.reshape(T, D)
    logits = (hf @ w_router + b_router).astype(jnp.float32)
    top_val, top_idx = lax.top_k(logits, TOP_K)
    top_w = jax.nn.softmax(top_val, axis=-1)
    e_flat = top_idx.reshape(-1)
    tok_flat = jnp.repeat(jnp.arange(T, dtype=jnp.int32), TOP_K)
    w_flat = top_w.reshape(-1)
    order = jnp.argsort(e_flat)
    e_sorted = e_flat[order]
    counts = jnp.bincount(e_flat, length=N_EXPERTS)
    starts = jnp.cumsum(counts) - counts
    padded = (counts + EXPERT_BLOCK - 1) // EXPERT_BLOCK * EXPERT_BLOCK
    pends = jnp.cumsum(padded)
    pstarts = pends - padded
    dest = pstarts[e_sorted] + (jnp.arange(T * TOP_K) - starts[e_sorted])
    P = T * TOP_K + N_EXPERTS * EXPERT_BLOCK
    n_blocks = P // EXPERT_BLOCK
    buf_tok = jnp.zeros((P,), jnp.int32).at[dest].set(tok_flat[order])
    buf_w = jnp.zeros((P,), jnp.float32).at[dest].set(w_flat[order])
    blk_e = jnp.minimum(jnp.searchsorted(pends, jnp.arange(n_blocks) * EXPERT_BLOCK, side='right'),
                        N_EXPERTS - 1)
    xb = hf[buf_tok].reshape(n_blocks, EXPERT_BLOCK, D)

    def expert_block(args):
        xblk, e = args
        gu = xblk @ w_gate_up[e] + b_gate_up[e]
        gate, up = gu[:, :D_FF], gu[:, D_FF:]
        gate = jnp.minimum(gate, SWIGLU_LIMIT)
        up = jnp.clip(up, -SWIGLU_LIMIT, SWIGLU_LIMIT)
        act = gate * jax.nn.sigmoid(SWIGLU_ALPHA * gate) * (up + 1)
        return act @ w_down[e] + b_down[e]

    yb = lax.map(expert_block, (xb, blk_e)).reshape(P, D)
    y = jax.ops.segment_sum(yb.astype(jnp.float32) * buf_w[:, None], buf_tok, num_segments=T)
    return y.astype(h.dtype).reshape(Bn, S, D)


def setup_inputs(seed: int = 0) -> dict:
    key = jax.random.key(seed)
    ks = jax.random.split(key, 21)

    def nrm(k, shape, scale):
        return jax.random.normal(k, shape, jnp.float32) * scale

    def gain(k, shape):
        return 1.0 + 0.1 * jax.random.normal(k, shape, jnp.float32)

    L = DEPTH
    return {
        'x': nrm(ks[0], (BATCH, SEQ, D_MODEL), 1.0),
        'c': nrm(ks[1], (BATCH, D_MODEL), 1.0),
        'w_ada': nrm(ks[2], (L, D_MODEL, 6 * D_MODEL), D_MODEL ** -0.5),
        'b_ada': nrm(ks[3], (L, 6 * D_MODEL), 0.02),
        'g_mix_pre': gain(ks[4], (L, D_MODEL)),
        'g_mix_post': gain(ks[5], (L, D_MODEL)),
        'g_ffn_pre': gain(ks[6], (L, D_MODEL)),
        'g_ffn_post': gain(ks[7], (L, D_MODEL)),
        'w_in': nrm(ks[8], (L, D_MODEL, D_IN), D_MODEL ** -0.5),
        'g_rec_out': gain(ks[9], (L, D_REC)),
        'w_branch_rec': nrm(ks[10], (L, D_REC, D_MODEL), D_REC ** -0.5),
        'w_branch_att': nrm(ks[11], (L, D_ATT_OUT, D_MODEL), D_ATT_OUT ** -0.5),
        'w_o': nrm(ks[12], (L, D_MODEL, D_MODEL), D_MODEL ** -0.5),
        'w_router': nrm(ks[13], (L, D_MODEL, N_EXPERTS), D_MODEL ** -0.5),
        'b_router': nrm(ks[14], (L, N_EXPERTS), 0.01),
        'w_gate_up': nrm(ks[15], (L, N_EXPERTS, D_MODEL, 2 * D_FF), D_MODEL ** -0.5),
        'b_gate_up': nrm(ks[16], (L, N_EXPERTS, 2 * D_FF), 0.02),
        'w_down': nrm(ks[17], (L, N_EXPERTS, D_FF, D_MODEL), D_FF ** -0.5),
        'b_down': nrm(ks[18], (L, N_EXPERTS, D_MODEL), 0.02),
        'rec_lb_table': nrm(ks[19], (2, DEPTH + 1, D_REC), 1.0),
        'rel_bias': nrm(ks[20], (NUM_BUCKETS, ATT_HEADS), 0.5),
    }


def reference(x, c, w_ada, b_ada, g_mix_pre, g_mix_post, g_ffn_pre, g_ffn_post, w_in, g_rec_out,
              w_branch_rec, w_branch_att, w_o, w_router, b_router, w_gate_up, b_gate_up, w_down,
              b_down, rec_lb_table, rel_bias):
    lb_all = jnp.cumsum(jax.nn.softmax(rec_lb_table.astype(jnp.float32), axis=1), axis=1)
    cond = jax.nn.silu(c)
    for layer in range(DEPTH):
        ada = (cond @ w_ada[layer] + b_ada[layer])[:, None, :]
        sh_m, sc_m, gt_m, sh_f, sc_f, gt_f = jnp.split(ada, 6, axis=-1)
        h = modulate(rms_norm(x, g_mix_pre[layer]), sh_m, sc_m)
        y = hybrid_mixer(h, w_in[layer], lb_all[:, layer], g_rec_out[layer], rel_bias,
                         w_branch_rec[layer], w_branch_att[layer], w_o[layer])
        x = x + gt_m * rms_norm(y, g_mix_post[layer])
        h = modulate(rms_norm(x, g_ffn_pre[layer]), sh_f, sc_f)
        y = moe_ffn(h, w_router[layer], b_router[layer], w_gate_up[layer], b_gate_up[layer],
                    w_down[layer], b_down[layer])
        x = x + gt_f * rms_norm(y, g_ffn_post[layer])
    return x
```

```cpp
#include <hip/hip_runtime.h>
#include <cstdio>
#include <cstdint>

typedef unsigned short bf16_t;
constexpr int T = 8192, SEQ = 4096, D = 2048, DREC = 1024, DATT = 1536, DAO = 512, DIN = 13824, NE = 32, DFF = 2048;
constexpr int PMAX = 40960;
constexpr int NTMAX = PMAX / 256;
constexpr float RMS_EPS = 1e-6f;

constexpr size_t MiB = 1ull << 20;
constexpr size_t WS_CTL = 0;
constexpr size_t WS_ADA = 2 * MiB;
constexpr size_t WS_LB = WS_ADA + 128 * 1024;
constexpr size_t WS_POS = 3 * MiB;
constexpr size_t WS_STOK = 4 * MiB;
constexpr size_t WS_SW = 5 * MiB;
constexpr size_t WS_TILE = WS_SW + 256 * 1024;
constexpr size_t WS_XN = 8 * MiB;
constexpr size_t WS_QR = WS_XN + 32 * MiB;
constexpr size_t WS_VR = WS_QR + 16 * MiB;
constexpr size_t WS_LFF = WS_VR + 16 * MiB;
constexpr size_t WS_LFB = WS_LFF + 32 * MiB;
constexpr size_t WS_GO = WS_LFB + 32 * MiB;
constexpr size_t WS_QA = WS_GO + 16 * MiB;
constexpr size_t WS_KA = WS_QA + 24 * MiB;
constexpr size_t WS_VA = WS_KA + 24 * MiB;
constexpr size_t WS_GR = WS_VA + 24 * MiB;
constexpr size_t WS_GA = WS_GR + 32 * MiB;
constexpr size_t WS_OFB = WS_GA + 32 * MiB;
constexpr size_t WS_OREC = WS_OFB + 64 * MiB;
constexpr size_t WS_OATT = WS_OREC + 16 * MiB;
constexpr size_t WS_YR = WS_OATT + 8 * MiB;
constexpr size_t WS_MG = WS_YR + 64 * MiB;
constexpr size_t WS_Y = WS_MG + 32 * MiB;
constexpr size_t WS_H2 = WS_Y + 64 * MiB;
constexpr size_t WS_XS = WS_H2 + 32 * MiB;
constexpr size_t WS_ACT = WS_XS + 160 * MiB;
constexpr size_t WS_YB = WS_ACT + 160 * MiB;
constexpr size_t WS_WIN_T = WS_YB + 160 * MiB;
constexpr size_t WS_WBR_T = WS_WIN_T + 56 * MiB;
constexpr size_t WS_WBA_T = WS_WBR_T + 4 * MiB;
constexpr size_t WS_WO_T = WS_WBA_T + 4 * MiB;
constexpr size_t WS_WGU_T = WS_WO_T + 8 * MiB;
constexpr size_t WS_WDN_T = WS_WGU_T + 512 * MiB;
constexpr size_t WS_END = WS_WDN_T + 256 * MiB;
constexpr size_t WS_H2L = (size_t)3000 * MiB;
constexpr size_t WS_WRT = (size_t)3040 * MiB;
constexpr size_t WS_TOP = (size_t)3200 * MiB;
constexpr int CW_CNT = 1024;
constexpr int CW_CUR = 4096;

__device__ __forceinline__ float bf2f(bf16_t b) { return __uint_as_float(((unsigned)b) << 16); }
__device__ __forceinline__ bf16_t f2bf(float f) { unsigned u = __float_as_uint(f); u += 0x7fffu + ((u >> 16) & 1u); return (bf16_t)(u >> 16); }
__device__ __forceinline__ float wave_sum(float v) {
#pragma unroll
    for (int o = 1; o < 64; o <<= 1) v += __shfl_xor(v, o);
    return v;
}
struct ProjOut { bf16_t *QR, *VR, *GO, *QA, *KA, *VA, *GR, *GA; float *LFF, *LFB; const float* lb; };
__device__ __forceinline__ int t5_bucket(int rel) {
    const int ret = rel > 0 ? 16 : 0, n = rel < 0 ? -rel : rel;
    if (n < 8) return ret + n;
    int large = 8 + (int)(logf((float)n / 8.0f) / 4.852030263919617f * 8.0f);
    large = large < 15 ? large : 15;
    return ret + large;
}

#define GAS __attribute__((address_space(1)))
#define LAS __attribute__((address_space(3)))
typedef unsigned v4u __attribute__((ext_vector_type(4)));
typedef float f32x4 __attribute__((ext_vector_type(4)));
#define LDS_WAIT() asm volatile("s_waitcnt lgkmcnt(0)" ::: "memory")
#define VM_WAIT() asm volatile("s_waitcnt vmcnt(0)" ::: "memory")
typedef float f32x2_t __attribute__((ext_vector_type(2)));
typedef __bf16 bf16x2_t __attribute__((ext_vector_type(2)));
__device__ __forceinline__ unsigned pk2(float lo, float hi) { const f32x2_t v = {lo, hi}; const bf16x2_t b = __builtin_convertvector(v, bf16x2_t); return __builtin_bit_cast(unsigned, b); }
__device__ __forceinline__ float bflo(unsigned u) { return __uint_as_float(u << 16); }
__device__ __forceinline__ float bfhi(unsigned u) { return __uint_as_float(u & 0xffff0000u); }
__device__ __forceinline__ float fsig(float v) { return __builtin_amdgcn_rcpf(1.0f + __expf(-v)); }

#ifndef PG8_AUX
#define PG8_AUX 0
#endif
namespace pg8 {
#define PG8_LAS __attribute__((address_space(3)))
typedef short bf16x8 __attribute__((ext_vector_type(8)));
typedef unsigned u32x4 __attribute__((ext_vector_type(4)));
constexpr int BM = 256, BK = 64, HALF = 128, HTB = HALF * BK * 2, STAGE_BYTES = 8 * HTB, NXCD = 8, WGM = 8;
__host__ __device__ __forceinline__ int lds_byte(int r, int c) { const int st = (r >> 4) * 2 + (c >> 5), rr = r & 15, cc = c & 31, ob = rr * 64 + cc * 2; return st * 1024 + (ob ^ (((ob >> 9) & 1) << 5)); }
__host__ __device__ __forceinline__ void stage_rc(int b, int& R, int& C) { const int st = b / 1024, sb = b % 1024, swz = sb ^ (((sb >> 9) & 1) << 5); R = (st >> 1) * 16 + swz / 64; C = (st & 1) * 32 + (swz % 64) / 2; }
__host__ __device__ __forceinline__ int perm32(int rho) { const int n = rho >> 4, i = rho & 15; return 8 * (i >> 2) + 4 * n + (i & 3); }
typedef int v8i __attribute__((ext_vector_type(8)));
typedef int v4i __attribute__((ext_vector_type(4)));
template <bool F8> struct FragSel { struct A_t { bf16x8 v[4][2]; }; struct B_t { bf16x8 v[2][2]; }; };
template <> struct FragSel<true> { struct A_t { v8i v[4]; }; struct B_t { v8i v[2]; }; };
__device__ __forceinline__ v8i cat16(bf16x8 lo, bf16x8 hi) { const v4i a = __builtin_bit_cast(v4i, lo), b = __builtin_bit_cast(v4i, hi); return __builtin_shufflevector(a, b, 0, 1, 2, 3, 4, 5, 6, 7); }
struct Unit { int pm, pn, pb, e; };
struct Gemm { const bf16_t* A; const bf16_t* Bt; int K; const int* rowidx; };
struct StaticOrder {
    int nM, nN, nwg, G, c;
    __device__ void init(int M, int N, int G_, int c_) { nM = M / BM; nN = N / BM; nwg = nM * nN; G = G_; c = c_; }
    __device__ bool next(int i, Unit& u) const {
        const long L = (long)i * G + c; if (L >= nwg) return false;
        int wgid = (int)L; { const int q = nwg / NXCD, r = nwg % NXCD, xcd = wgid % NXCD, off = wgid / NXCD; wgid = (xcd < r ? xcd * (q + 1) : r * (q + 1) + (xcd - r) * q) + off; }
        const int nig = WGM * nN, gid = wgid / nig, fm = gid * WGM, gsz = (nM - fm) < WGM ? (nM - fm) : WGM;
        u.pm = fm + ((wgid % nig) % gsz); u.pn = (wgid % nig) / gsz; u.pb = u.pn; u.e = 0; return true;
    }
};
__device__ const signed char kProjPerm[54] = {38, 40, 42, 44, 46, 48, 50, 52, 16, 18, 0, 2, 8, 10, 12, 14, 4, 6, 20, 22, 24, 26, 28, 30, 32, 34, 36, 39, 41, 43, 45, 47, 49, 51, 53, 17, 19, 1, 3, 9, 11, 13, 15, 5, 7, 21, 23, 25, 27, 29, 31, 33, 35, 37};
struct ProjOrder : StaticOrder {
    __device__ bool next(int i, Unit& u) const { if (!StaticOrder::next(i, u)) return false; u.pn = kProjPerm[u.pn]; u.pb = u.pn; return true; }
};
struct ListOrder {
    const LAS int* tab; int n;
    __device__ bool next(int i, Unit& u) const { if (i >= n) return false; u.pm = tab[4 * i]; u.pn = tab[4 * i + 1]; u.pb = tab[4 * i + 2]; u.e = tab[4 * i + 3]; return true; }
};

template <class Epi, class Sched, bool ALIGN_EPI, bool SP2 = true, bool GATHER = false, bool F8 = false>
__device__ __forceinline__ void gemm_phase(PG8_LAS unsigned char* lds, const Gemm g, const Sched& S, const Epi& E) {
    const int tid = threadIdx.x, wid = __builtin_amdgcn_readfirstlane(tid >> 6), lane = tid & 63, wr = wid >> 2, wc = wid & 3, fr = lane & 15, fq = lane >> 4;
    const int K = g.K, rowb = F8 ? K : 2 * K, nt = rowb / 128;
    unsigned voffB[2];
#pragma unroll
    for (int i = 0; i < 2; ++i) { int R, C; stage_rc(tid * 16 + i * 8192, R, C); const int Rb = Epi::PERM ? ((R & ~31) + perm32(R & 31)) : R;
        voffB[i] = (unsigned)(Rb * rowb + C * 2); }
#define PG8_SET_AOFF(o, u) do { _Pragma("unroll") for (int _h = 0; _h < 2; ++_h) _Pragma("unroll") for (int _i = 0; _i < 2; ++_i) { int _R, _C; stage_rc((int)threadIdx.x * 16 + _i * 8192, _R, _C); int _row = (u).pm * BM + _h * HALF + _R; \
        if (GATHER) { const int _t = g.rowidx[((u).e & 31) * 8192 + (((u).e >> 12) & 63) * BM + _h * HALF + _R]; _row = _t < 0 ? 0 : _t; } (o)[_h][_i] = (unsigned)(_row * rowb + _C * 2); } } while (0)
#define PG8_STAGE_A(bufoff, o0, o1, kb) do { __builtin_amdgcn_global_load_lds((const unsigned*)((const char*)g.A + (o0) + (kb)), (PG8_LAS unsigned*)(lds + (bufoff) + ldsw), 16, 0, PG8_AUX); \
        __builtin_amdgcn_global_load_lds((const unsigned*)((const char*)g.A + (o1) + (kb)), (PG8_LAS unsigned*)(lds + (bufoff) + ldsw + 8192), 16, 0, PG8_AUX); } while (0)
    const size_t kstep = (size_t)(BK * 2);
    const size_t hstep = (size_t)HALF * rowb;
    const size_t tstep = 2 * hstep;
    const unsigned ldsw = (unsigned)wid * 1024u;
    const int aoff = F8 ? lds_byte(wr * 64 + fr, fq * 16) : lds_byte(wr * 64 + fr, fq * 8), boff = F8 ? lds_byte(wc * 32 + fr, fq * 16) : lds_byte(wc * 32 + fr, fq * 8);
#define PG8_SA(b, h) (((b) * 2 + (h)) * HTB)
#define PG8_SB(b, h) ((4 + (b) * 2 + (h)) * HTB)
#define PG8_STAGE(bufoff, gbase, voff) do { _Pragma("unroll") for (int _i = 0; _i < 2; ++_i) \
        __builtin_amdgcn_global_load_lds((const unsigned*)((const char*)(gbase) + (voff)[_i]), (PG8_LAS unsigned*)(lds + (bufoff) + ldsw + _i * 8192), 16, 0, PG8_AUX); } while (0)
#define PG8_LDA(dst, b, h) do { _Pragma("unroll") for (int m = 0; m < 4; ++m) { \
        if constexpr (F8) dst.v[m] = cat16(*(const PG8_LAS bf16x8*)(lds + PG8_SA(b, h) + aoff + m * 2048), *(const PG8_LAS bf16x8*)(lds + PG8_SA(b, h) + aoff + m * 2048 + 16)); \
        else { _Pragma("unroll") for (int k = 0; k < 2; ++k) dst.v[m][k] = *(const PG8_LAS bf16x8*)(lds + PG8_SA(b, h) + aoff + m * 2048 + k * 1024); } } } while (0)
#define PG8_LDB(dst, b, h) do { _Pragma("unroll") for (int n = 0; n < 2; ++n) { \
        if constexpr (F8) dst.v[n] = cat16(*(const PG8_LAS bf16x8*)(lds + PG8_SB(b, h) + boff + n * 2048), *(const PG8_LAS bf16x8*)(lds + PG8_SB(b, h) + boff + n * 2048 + 16)); \
        else { _Pragma("unroll") for (int k = 0; k < 2; ++k) dst.v[n][k] = *(const PG8_LAS bf16x8*)(lds + PG8_SB(b, h) + boff + n * 2048 + k * 1024); } } } while (0)
#define PG8_MMA(ai, bj, At, Bt) do { __builtin_amdgcn_s_setprio(1); _Pragma("unroll") for (int m = 0; m < 4; ++m) _Pragma("unroll") for (int n = 0; n < 2; ++n) { \
        if constexpr (F8) asm volatile("v_mfma_scale_f32_16x16x128_f8f6f4 %0, %1, %2, %0, %3, %3 op_sel_hi:[0,0,0]" : "+v"(acc[ai][bj][m][n]) : "v"(Bt.v[n]), "v"(At.v[m]), "v"(f8scale)); \
        else { _Pragma("unroll") for (int k = 0; k < 2; ++k) acc[ai][bj][m][n] = __builtin_amdgcn_mfma_f32_16x16x32_bf16(Bt.v[n][k], At.v[m][k], acc[ai][bj][m][n], 0, 0, 0); } } \
        __builtin_amdgcn_s_setprio(0); } while (0)
#define PG8_WAIT_V(n) asm volatile("s_waitcnt vmcnt(" #n ")" ::: "memory")
#define PG8_WAIT_L(n) asm volatile("s_waitcnt lgkmcnt(" #n ")" ::: "memory")
#define PG8_BAR __builtin_amdgcn_s_barrier()
#define PG8_SCHED __builtin_amdgcn_sched_barrier(0)
    Unit cur, nxt; int ui = 0;
    if (!S.next(0, cur)) return;
    f32x4 acc[2][2][4][2];
#pragma unroll
    for (int a = 0; a < 2; ++a)
#pragma unroll
        for (int b = 0; b < 2; ++b)
#pragma unroll
            for (int m = 0; m < 4; ++m)
#pragma unroll
                for (int n = 0; n < 2; ++n) acc[a][b][m][n] = (f32x4){0.f, 0.f, 0.f, 0.f};
    int f8scale = 0x7f7f7f7f; asm volatile("" : "+v"(f8scale));
    typedef typename FragSel<F8>::A_t FragA; typedef typename FragSel<F8>::B_t FragB;
    FragA At; FragB B0, B1;
    const char* cB = (const char*)g.Bt + (size_t)cur.pb * tstep;
    unsigned AGO_[2][2], NAGO_[2][2]; PG8_SET_AOFF(AGO_, cur);
    if constexpr (SP2) {
    PG8_STAGE(PG8_SB(0, 0), cB, voffB); PG8_STAGE(PG8_SB(0, 1), cB + hstep, voffB); PG8_STAGE_A(PG8_SA(0, 0), AGO_[0][0], AGO_[0][1], 0); PG8_STAGE_A(PG8_SA(0, 1), AGO_[1][0], AGO_[1][1], 0);
    if (wr == 1) PG8_BAR;
    PG8_WAIT_V(2); PG8_BAR;
    PG8_STAGE(PG8_SB(1, 0), cB + kstep, voffB); PG8_STAGE_A(PG8_SA(1, 0), AGO_[0][0], AGO_[0][1], kstep); PG8_STAGE(PG8_SB(1, 1), cB + hstep + kstep, voffB);
    PG8_WAIT_V(6); PG8_BAR;
    }
    for (;;) {
        const bool has_next = S.next(ui + 1, nxt);
        const char* nB = has_next ? (const char*)g.Bt + (size_t)nxt.pb * tstep : cB;
        if (has_next) { PG8_SET_AOFF(NAGO_, nxt); } else {
#pragma unroll
            for (int _h = 0; _h < 2; ++_h)
#pragma unroll
                for (int _i = 0; _i < 2; ++_i) NAGO_[_h][_i] = AGO_[_h][_i]; }
        for (int t = 0; t < nt; t += 2) {
            const bool last = (t == nt - 2);
            const unsigned k1 = (unsigned)(t + 1) * (unsigned)kstep, k2 = last ? 0u : (unsigned)(t + 2) * (unsigned)kstep, k3 = k2 + (unsigned)kstep;
            const unsigned p00 = last ? NAGO_[0][0] : AGO_[0][0], p01 = last ? NAGO_[0][1] : AGO_[0][1], p10 = last ? NAGO_[1][0] : AGO_[1][0], p11 = last ? NAGO_[1][1] : AGO_[1][1];
            const char* b2 = last ? nB : cB + (size_t)(t + 2) * kstep; const char* b3 = b2 + kstep;
            PG8_LDB(B0, 0, 0); PG8_LDB(B1, 0, 1); PG8_SCHED; PG8_LDA(At, 0, 0); PG8_STAGE_A(PG8_SA(1, 1), AGO_[1][0], AGO_[1][1], k1);
            PG8_WAIT_V(8); PG8_WAIT_L(0); PG8_BAR; PG8_MMA(0, 0, At, B0); PG8_MMA(0, 1, At, B1); PG8_BAR; PG8_SCHED;
            PG8_LDA(At, 0, 1); PG8_STAGE(PG8_SB(0, 0), b2, voffB); PG8_STAGE(PG8_SB(0, 1), b2 + hstep, voffB); PG8_STAGE_A(PG8_SA(0, 0), p00, p01, k2);
            PG8_WAIT_V(8); PG8_WAIT_L(0); PG8_BAR; if (!F8 || !(cur.e & 256)) { PG8_MMA(1, 0, At, B0); PG8_MMA(1, 1, At, B1); } PG8_BAR; PG8_SCHED;
            PG8_LDB(B0, 1, 0); PG8_LDB(B1, 1, 1); PG8_SCHED; PG8_LDA(At, 1, 0); PG8_STAGE_A(PG8_SA(0, 1), p10, p11, k2);
            PG8_WAIT_V(8); PG8_WAIT_L(0); PG8_BAR; PG8_MMA(0, 0, At, B0); PG8_MMA(0, 1, At, B1); PG8_BAR; PG8_SCHED;
            PG8_LDA(At, 1, 1); PG8_STAGE(PG8_SB(1, 0), b3, voffB); PG8_STAGE(PG8_SB(1, 1), b3 + hstep, voffB); PG8_STAGE_A(PG8_SA(1, 0), p00, p01, k3);
            PG8_WAIT_V(8); PG8_WAIT_L(0); PG8_BAR; if (!F8 || !(cur.e & 256)) { PG8_MMA(1, 0, At, B0); PG8_MMA(1, 1, At, B1); } PG8_BAR; PG8_SCHED;
        }
        if constexpr (ALIGN_EPI) { if (wr == 0) PG8_BAR; }
        E(acc, cur, wr, wc, fr, fq);
        if (!has_next) break;
#pragma unroll
        for (int a = 0; a < 2; ++a)
#pragma unroll
            for (int b = 0; b < 2; ++b)
#pragma unroll
                for (int m = 0; m < 4; ++m)
#pragma unroll
                    for (int n = 0; n < 2; ++n) acc[a][b][m][n] = (f32x4){0.f, 0.f, 0.f, 0.f};
        cur = nxt; cB = nB; ++ui;
#pragma unroll
        for (int _h = 0; _h < 2; ++_h)
#pragma unroll
            for (int _i = 0; _i < 2; ++_i) AGO_[_h][_i] = NAGO_[_h][_i];
        if constexpr (ALIGN_EPI) { if (wr == 1) PG8_BAR; }
    }
    PG8_WAIT_V(0);
    if constexpr (!ALIGN_EPI) { if (wr == 0) PG8_BAR; }
    PG8_BAR;
#undef PG8_SA
#undef PG8_SB
#undef PG8_STAGE
#undef PG8_STAGE_A
#undef PG8_SET_AOFF
#undef PG8_LDA
#undef PG8_LDB
#undef PG8_MMA
#undef PG8_WAIT_V
#undef PG8_WAIT_L
#undef PG8_BAR
#undef PG8_SCHED
}
}
typedef pg8::bf16x8 bfx8;
#define MFMA16(a, b, c) __builtin_amdgcn_mfma_f32_16x16x32_bf16(a, b, c, 0, 0, 0)

typedef f32x4 acc_t[2][2][4][2];
__device__ __forceinline__ v4u pack8(const float (&x)[8]) { v4u w; w.x = pk2(x[0], x[1]); w.y = pk2(x[2], x[3]); w.z = pk2(x[4], x[5]); w.w = pk2(x[6], x[7]); return w; }
typedef unsigned u32x2 __attribute__((ext_vector_type(2)));
__device__ __forceinline__ u32x2 pack8_fp8(const float (&x)[8]) {
    unsigned lo = 0, hi = 0;
    lo = __builtin_amdgcn_cvt_pk_fp8_f32(x[0], x[1], lo, false); lo = __builtin_amdgcn_cvt_pk_fp8_f32(x[2], x[3], lo, true);
    hi = __builtin_amdgcn_cvt_pk_fp8_f32(x[4], x[5], hi, false); hi = __builtin_amdgcn_cvt_pk_fp8_f32(x[6], x[7], hi, true);
    return (u32x2){lo, hi};
}
__device__ __forceinline__ void st_bf16x8(bf16_t* p, const float (&x)[8]) { v4u w; w.x = pk2(x[0], x[1]); w.y = pk2(x[2], x[3]); w.z = pk2(x[4], x[5]); w.w = pk2(x[6], x[7]); *(v4u*)p = w; }
__device__ __forceinline__ void st_f32x8_nt(float* p, const float (&x)[8]) { __builtin_nontemporal_store((f32x4){x[0], x[1], x[2], x[3]}, (f32x4*)p); __builtin_nontemporal_store((f32x4){x[4], x[5], x[6], x[7]}, (f32x4*)(p + 4)); }
__device__ __forceinline__ void st_f32x8(float* p, const float (&x)[8]) { *(f32x4*)p = (f32x4){x[0], x[1], x[2], x[3]}; *(f32x4*)(p + 4) = (f32x4){x[4], x[5], x[6], x[7]}; }
#define ACC8(x, acc, ai, bj, m) float x[8]; { const f32x4 _a = acc[ai][bj][m][0], _b = acc[ai][bj][m][1]; x[0] = _a[0]; x[1] = _a[1]; x[2] = _a[2]; x[3] = _a[3]; x[4] = _b[0]; x[5] = _b[1]; x[6] = _b[2]; x[7] = _b[3]; }

struct EpiProjT {
    static constexpr bool PERM = true;
    ProjOut P;
    template <int KIND> __device__ __forceinline__ void tile(const acc_t& acc, void* dst, int ld, int cb, const float* lbp, int row0, int wc, int fq) const {
        const int c0 = cb + wc * 32 + 8 * fq;
        float lbv[2][8];
        if (KIND == 2) {
#pragma unroll
            for (int bj = 0; bj < 2; ++bj) { const f32x4 a = *(const f32x4*)(lbp + c0 + 128 * bj), b = *(const f32x4*)(lbp + c0 + 128 * bj + 4);
                lbv[bj][0] = a[0]; lbv[bj][1] = a[1]; lbv[bj][2] = a[2]; lbv[bj][3] = a[3]; lbv[bj][4] = b[0]; lbv[bj][5] = b[1]; lbv[bj][6] = b[2]; lbv[bj][7] = b[3]; }
        }
#pragma unroll
        for (int ai = 0; ai < 2; ++ai)
#pragma unroll
            for (int m = 0; m < 4; ++m) {
                const size_t rowoff = (size_t)(row0 + ai * 128 + m * 16) * ld;
#pragma unroll
                for (int bj = 0; bj < 2; ++bj) {
                    ACC8(x, acc, ai, bj, m);
                    const int col = c0 + 128 * bj;
                    if (KIND == 2) {
#pragma unroll
                        for (int j = 0; j < 8; ++j) { const float l = lbv[bj][j]; x[j] = __logf(l + (1.0f - l) * fsig(x[j])); }
                        { typedef _Float16 h2_t __attribute__((ext_vector_type(2))); v4u w;
                          w.x = __builtin_bit_cast(unsigned, (h2_t){(_Float16)x[0], (_Float16)x[1]}); w.y = __builtin_bit_cast(unsigned, (h2_t){(_Float16)x[2], (_Float16)x[3]});
                          w.z = __builtin_bit_cast(unsigned, (h2_t){(_Float16)x[4], (_Float16)x[5]}); w.w = __builtin_bit_cast(unsigned, (h2_t){(_Float16)x[6], (_Float16)x[7]});
                          *(v4u*)((unsigned short*)dst + rowoff + col) = w; }
                    } else {
#pragma unroll
                        for (int j = 0; j < 8; ++j) { if (KIND == 0) x[j] = x[j] * fsig(x[j]); if (KIND == 3) x[j] = fsig(x[j]); if (KIND == 4) x[j] *= 0.08838834764831845f; }
                        st_bf16x8((bf16_t*)dst + rowoff + col, x);
                    }
                }
            }
    }
    __device__ __forceinline__ void operator()(const acc_t& acc, const pg8::Unit& u, int wr, int wc, int fr, int fq) const {
        const int row0 = u.pm * 256 + wr * 64 + fr, colt = u.pn * 256;
        if (colt < 1024) tile<0>(acc, P.QR, 1024, colt, nullptr, row0, wc, fq);
        else if (colt < 2048) tile<1>(acc, P.VR, 1024, colt - 1024, nullptr, row0, wc, fq);
        else if (colt < 3072) tile<2>(acc, P.LFF, 1024, colt - 2048, P.lb, row0, wc, fq);
        else if (colt < 4096) tile<2>(acc, P.LFB, 1024, colt - 3072, P.lb + 1024, row0, wc, fq);
        else if (colt < 5120) tile<3>(acc, P.GO, 1024, colt - 4096, nullptr, row0, wc, fq);
        else if (colt < 6656) tile<4>(acc, P.QA, 1536, colt - 5120, nullptr, row0, wc, fq);
        else if (colt < 8192) tile<1>(acc, P.KA, 1536, colt - 6656, nullptr, row0, wc, fq);
        else if (colt < 9728) tile<1>(acc, P.VA, 1536, colt - 8192, nullptr, row0, wc, fq);
        else if (colt < 11776) tile<3>(acc, P.GR, 2048, colt - 9728, nullptr, row0, wc, fq);
        else tile<3>(acc, P.GA, 2048, colt - 11776, nullptr, row0, wc, fq);
    }
};
struct EpiF32T {
    static constexpr bool PERM = true;
    float* C; int ldc;
    __device__ __forceinline__ void operator()(const acc_t& acc, const pg8::Unit& u, int wr, int wc, int fr, int fq) const {
        const int row0 = u.pm * 256 + wr * 64 + fr, c0 = u.pn * 256 + wc * 32 + 8 * fq;
#pragma unroll
        for (int ai = 0; ai < 2; ++ai)
#pragma unroll
            for (int m = 0; m < 4; ++m)
#pragma unroll
                for (int bj = 0; bj < 2; ++bj) { ACC8(x, acc, ai, bj, m); st_f32x8(C + (size_t)(row0 + ai * 128 + m * 16) * ldc + c0 + 128 * bj, x); }
    }
};
struct EpiBf16T {
    static constexpr bool PERM = true;
    bf16_t* C; int ldc;
    __device__ __forceinline__ void operator()(const acc_t& acc, const pg8::Unit& u, int wr, int wc, int fr, int fq) const {
        const int row0 = u.pm * 256 + wr * 64 + fr, c0 = u.pn * 256 + wc * 32 + 8 * fq;
#pragma unroll
        for (int ai = 0; ai < 2; ++ai)
#pragma unroll
            for (int m = 0; m < 4; ++m)
#pragma unroll
                for (int bj = 0; bj < 2; ++bj) { ACC8(x, acc, ai, bj, m); st_bf16x8(C + (size_t)(row0 + ai * 128 + m * 16) * ldc + c0 + 128 * bj, x); }
    }
};
struct EpiMergeT {
    static constexpr bool PERM = true;
    const bf16_t* YR; const bf16_t* GR; const bf16_t* GA; bf16_t* MG;
    __device__ __forceinline__ void operator()(const acc_t& acc, const pg8::Unit& u, int wr, int wc, int fr, int fq) const {
        const int row0 = u.pm * 256 + wr * 64 + fr, c0 = u.pn * 256 + wc * 32 + 8 * fq;
#pragma unroll
        for (int ai = 0; ai < 2; ++ai)
#pragma unroll
            for (int m = 0; m < 4; ++m)
#pragma unroll
                for (int bj = 0; bj < 2; ++bj) {
                    ACC8(x, acc, ai, bj, m);
                    const size_t o = (size_t)(row0 + ai * 128 + m * 16) * D + c0 + 128 * bj;
                    const v4u gr = *(const v4u*)(GR + o), ga = *(const v4u*)(GA + o), yr = *(const v4u*)(YR + o); const f32x4 y0 = {bflo(yr.x), bfhi(yr.x), bflo(yr.y), bfhi(yr.y)}, y1 = {bflo(yr.z), bfhi(yr.z), bflo(yr.w), bfhi(yr.w)};
                    x[0] = bflo(gr.x) * y0[0] + bflo(ga.x) * x[0]; x[1] = bfhi(gr.x) * y0[1] + bfhi(ga.x) * x[1];
                    x[2] = bflo(gr.y) * y0[2] + bflo(ga.y) * x[2]; x[3] = bfhi(gr.y) * y0[3] + bfhi(ga.y) * x[3];
                    x[4] = bflo(gr.z) * y1[0] + bflo(ga.z) * x[4]; x[5] = bfhi(gr.z) * y1[1] + bfhi(ga.z) * x[5];
                    x[6] = bflo(gr.w) * y1[2] + bflo(ga.w) * x[6]; x[7] = bfhi(gr.w) * y1[3] + bfhi(ga.w) * x[7];
                    st_bf16x8(MG + o, x);
                }
    }
};
struct EpiGateUpT {
    static constexpr bool PERM = true;
    const float* bgu; unsigned char* ACT;
    __device__ __forceinline__ void operator()(const acc_t& acc, const pg8::Unit& u, int wr, int wc, int fr, int fq) const {
        const int row0 = u.pm * 256 + wr * 64 + fr, c0 = u.pn * 128 + wc * 32 + 8 * fq;
        const float* bg = bgu + (size_t)(u.e & 255) * 2 * DFF + c0;
        float bgv[8], buv[8];
        { const f32x4 a = *(const f32x4*)bg, b = *(const f32x4*)(bg + 4), c = *(const f32x4*)(bg + DFF), d = *(const f32x4*)(bg + DFF + 4);
#pragma unroll
          for (int j = 0; j < 4; ++j) { bgv[j] = a[j]; bgv[4 + j] = b[j]; buv[j] = c[j]; buv[4 + j] = d[j]; } }
#pragma unroll
        for (int ai = 0; ai < 2; ++ai)
#pragma unroll
            for (int m = 0; m < 4; ++m) {
                ACC8(g, acc, ai, 0, m); ACC8(up, acc, ai, 1, m);
#pragma unroll
                for (int j = 0; j < 8; ++j) { const float gt = fminf(g[j] * 0.015625f + bgv[j], 7.0f), uu = fminf(fmaxf(up[j] * 0.015625f + buv[j], -7.0f), 7.0f); g[j] = gt * fsig(1.702f * gt) * (uu + 1.0f); }
                *(u32x2*)(ACT + (size_t)(row0 + ai * 128 + m * 16) * DFF + c0) = pack8_fp8(g);
            }
    }
};
struct EpiDownT {
    static constexpr bool PERM = true;
    const float* bd; const float* SW; bf16_t* YB;
    __device__ __forceinline__ void operator()(const acc_t& acc, const pg8::Unit& u, int wr, int wc, int fr, int fq) const {
        const int row0 = u.pm * 256 + wr * 64 + fr, c0 = u.pn * 256 + wc * 32 + 8 * fq;
        float bv[2][8];
#pragma unroll
        for (int bj = 0; bj < 2; ++bj) { const float* bp = bd + (size_t)(u.e & 255) * D + c0 + 128 * bj; const f32x4 a = *(const f32x4*)bp, b = *(const f32x4*)(bp + 4);
#pragma unroll
            for (int j = 0; j < 4; ++j) { bv[bj][j] = a[j]; bv[bj][4 + j] = b[j]; } }
#pragma unroll
        for (int ai = 0; ai < 2; ++ai)
#pragma unroll
            for (int m = 0; m < 4; ++m) {
                const int row = row0 + ai * 128 + m * 16; const float w = SW[(u.e & 31) * 8192 + ((u.e >> 12) & 63) * 256 + (row - u.pm * 256)];
#pragma unroll
                for (int bj = 0; bj < 2; ++bj) { ACC8(x, acc, ai, bj, m);
#pragma unroll
                    for (int j = 0; j < 8; ++j) x[j] = (x[j] * 0.015625f + bv[bj][j]) * w;
                    st_bf16x8(YB + (size_t)row * D + c0 + 128 * bj, x); }
            }
    }
};

#define XB_TMO      128
#define XB_XCNT(j)  (256  + 64 * (j))
#define XB_XSUB(j)  (1280 + 64 * (j))
#define XB_XGEN(j)  (2304 + 64 * (j))
#define XB_TOP      3328
#define XB_TOPGEN   3392
#define XCD_BAR_WORDS 3456
#define XB_SPIN_CAP (1u << 18)
__device__ __forceinline__ unsigned xb_ld(unsigned* p)              { return __hip_atomic_load(p, __ATOMIC_RELAXED, __HIP_MEMORY_SCOPE_AGENT); }
__device__ __forceinline__ unsigned xb_add(unsigned* p, unsigned v) { return __hip_atomic_fetch_add(p, v, __ATOMIC_RELAXED, __HIP_MEMORY_SCOPE_AGENT); }
__device__ __forceinline__ unsigned xb_xcc_id() { return (unsigned)__builtin_amdgcn_s_getreg((3 << 11) | 20) & 0xFu; }
#define XB_SPIN(cond, bar) do { unsigned _sp = 0; while (cond) { __builtin_amdgcn_s_sleep(1); \
    if ((++_sp & 255u) == 0u) { if (xb_ld(&(bar)[XB_TMO])) break; if (_sp > XB_SPIN_CAP) { atomicAdd(&(bar)[XB_TMO], 1u); break; } } } } while (0)
struct XcdBarrier { unsigned* bar; unsigned x; volatile LAS unsigned* st; unsigned total; };
__device__ __forceinline__ XcdBarrier xcd_barrier_post(unsigned* bar, volatile LAS unsigned* st, unsigned total) {
    XcdBarrier b; b.bar = bar; b.x = xb_xcc_id(); b.st = st; b.total = total;
    if (threadIdx.x == 0) (void)xb_add(&bar[XB_XCNT(b.x)], 1u);
    return b;
}
__device__ __forceinline__ void xcd_barrier_complete(unsigned* bar, unsigned x, unsigned G, unsigned& nloc, unsigned& nx) {
    unsigned sum, cnt, mine, sp = 0u;
    for (;;) {
        sum = 0u; cnt = 0u; mine = 0u;
#pragma unroll
        for (unsigned j = 0; j < 16; ++j) { const unsigned c = xb_ld(&bar[XB_XCNT(j)]); sum += c; cnt += (c > 0u) ? 1u : 0u; mine = (j == x) ? c : mine; }
        if (sum == G) break;
        __builtin_amdgcn_s_sleep(1);
        if ((++sp & 255u) == 0u) { if (xb_ld(&bar[XB_TMO])) break; if (sp > XB_SPIN_CAP) { atomicAdd(&bar[XB_TMO], 1u); break; } }
    }
    nloc = mine > 0u ? mine : 1u; nx = cnt > 0u ? cnt : 1u;
}
__device__ __forceinline__ void xcd_barrier(const XcdBarrier& b) {
    asm volatile("s_waitcnt vmcnt(0)" ::: "memory");
    __syncthreads();
    if (threadIdx.x == 0) {
        unsigned* bar = b.bar;
        __builtin_amdgcn_s_waitcnt(0);
        unsigned nloc = b.st[0], nx = b.st[1];
        if (nloc == 0u) { xcd_barrier_complete(bar, b.x, b.total, nloc, nx); b.st[0] = nloc; b.st[1] = nx; }
        const unsigned old = xb_add(&bar[XB_XSUB(b.x)], 1u);
        const unsigned gen = old / nloc;
        if (old + 1u == (gen + 1u) * nloc) {
            __builtin_amdgcn_fence(__ATOMIC_RELEASE, "agent");
            asm volatile("s_waitcnt vmcnt(0)" ::: "memory");
            const unsigned og = xb_add(&bar[XB_TOP], 1u);
            const unsigned tg = og / nx;
            if (og + 1u == (tg + 1u) * nx) xb_add(&bar[XB_TOPGEN], 1u);
            else XB_SPIN(xb_ld(&bar[XB_TOPGEN]) == tg, bar);
            __builtin_amdgcn_fence(__ATOMIC_ACQUIRE, "agent");
            xb_add(&bar[XB_XGEN(b.x)], 1u);
            asm volatile("s_waitcnt vmcnt(0)" ::: "memory");
        } else {
            XB_SPIN(xb_ld(&bar[XB_XGEN(b.x)]) == gen, bar);
            __builtin_amdgcn_fence(__ATOMIC_ACQUIRE, "agent");
            asm volatile("s_waitcnt vmcnt(0)" ::: "memory");
        }
    }
    __syncthreads();
}

constexpr int NWAVES = 8;
constexpr int RING_BYTES = 131072, LDSCTL_OFF = RING_BYTES, LDS_BYTES = 163840;
constexpr int MISC_OFF = LDSCTL_OFF;
constexpr int RT_OFF = LDSCTL_OFF + 128;
constexpr int UL_OFF = LDSCTL_OFF + 512;
constexpr int CW_BAR = 8192;
constexpr int NPH = 13; constexpr int CW_DIAG_T = 20480 + 32;
struct Args { const float* in[21]; float* out; unsigned char* ws; int ph_lo, ph_hi, li, pad; };

struct Ctx { LAS unsigned char* lds; int tid, lane, wave, vcu, G; };

constexpr int M_IN = 16 * 108, M_BR = 8 * 16, M_BA = 4 * 16, M_O = 16 * 16, M_GU = 32 * 16 * 32, M_DN = 32 * 16 * 16, M_EXP = M_GU + M_DN, NMAC = M_IN + M_BR + M_BA + M_O + M_GU + M_DN;
constexpr int CW_Q0 = 6144 + 64, CW_Q1 = 6144 + 128, CW_Q2 = 6144 + 192, CW_Q3 = 6144 + 256;
constexpr int CONV_PER_32 = 5;
__device__ __forceinline__ void convert_stream(const Args& a, const Ctx& F, unsigned* Q, int lo, int hi) {
    unsigned char* ws = a.ws;
    struct Mac { const float* W; int ldw; unsigned char* dst; int ldd; int f8; int gu; int n0; };
    auto decode = [&](int r) -> Mac {
        Mac t; t.gu = 0; t.f8 = 0; t.n0 = 0; if (r < 0) r += M_EXP + M_O + M_BR + M_BA;
        if (r < M_GU) { const int e = r >> 9, rr = r & 511, kb = rr >> 5, nb = rr & 31;
            t.W = a.in[15] + (size_t)e * D * 4096 + (size_t)(128 * kb) * 4096 + 128 * nb; t.ldw = 4096; t.dst = ws + WS_WGU_T + (size_t)e * 4096 * 2048 + 128 * kb; t.ldd = 2048; t.f8 = 1; t.gu = 1; t.n0 = 128 * nb; }
        else if ((r -= M_GU) < M_DN) { const int e = r >> 8, rr = r & 255, kb = rr >> 4, nb = rr & 15;
            t.W = a.in[17] + (size_t)e * DFF * D + (size_t)(128 * kb) * D + 128 * nb; t.ldw = D; t.dst = ws + WS_WDN_T + ((size_t)e * 2048 + 128 * nb) * 2048 + 128 * kb; t.ldd = 2048; t.f8 = 1; }
        else if ((r -= M_DN) < M_O) { const int kb = r >> 4, nb = r & 15; t.W = a.in[12] + (size_t)(128 * kb) * D + 128 * nb; t.ldw = D; t.dst = ws + WS_WO_T + ((size_t)(128 * nb) * 2048 + 128 * kb) * 2; t.ldd = 2048 * 2; }
        else if ((r -= M_O) < M_BR) { const int kb = r >> 4, nb = r & 15; t.W = a.in[10] + (size_t)(128 * kb) * D + 128 * nb; t.ldw = D; t.dst = ws + WS_WBR_T + ((size_t)(128 * nb) * 1024 + 128 * kb) * 2; t.ldd = 1024 * 2; }
        else if ((r -= M_BR) < M_BA) { const int kb = r >> 4, nb = r & 15; t.W = a.in[11] + (size_t)(128 * kb) * D + 128 * nb; t.ldw = D; t.dst = ws + WS_WBA_T + ((size_t)(128 * nb) * 512 + 128 * kb) * 2; t.ldd = 512 * 2; }
        else { r -= M_BA; const int kb = r / 108, nb = r % 108; t.W = a.in[8] + (size_t)(128 * kb) * DIN + 128 * nb; t.ldw = DIN; t.dst = ws + WS_WIN_T + ((size_t)(128 * nb) * 2048 + 128 * kb) * 2; t.ldd = 2048 * 2; }
        return t;
    };
    const int lane = F.lane, w = F.wave;
#define P0_LOAD(rg, m) do { _Pragma("unroll") for (int i = 0; i < 8; ++i) rg[i] = __builtin_nontemporal_load((const f32x4*)((m).W + (size_t)(16 * w + 2 * i + (lane >> 5)) * (m).ldw + 4 * (lane & 31))); } while (0)
#define P0_STEP(rg, me, have_nxt, nxt_idx, buf) do { \
        LAS float* tile = (LAS float*)(F.lds + (buf) * 65536); \
        _Pragma("unroll") for (int i = 0; i < 8; ++i) { const int k = 16 * w + 2 * i + (lane >> 5); *(LAS f32x4*)(tile + k * 128 + ((4 * (lane & 31)) ^ (4 * ((k >> 3) & 7)))) = rg[i]; } \
        const Mac mcur = me; \
        if (have_nxt) { me = decode(nxt_idx); P0_LOAD(rg, me); } \
        __syncthreads(); \
        const int c = lane & 15; \
        _Pragma("unroll") for (int j = 0; j < 4; ++j) { const int nl = 16 * w + (lane >> 4) + 4 * j; float x[8]; \
            _Pragma("unroll") for (int i = 0; i < 8; ++i) x[i] = tile[(8 * c + i) * 128 + (nl ^ (4 * (c & 7)))]; \
            size_t row = (size_t)nl; \
            if (mcur.gu) { const int n = mcur.n0 + nl, half = n >> 11, nn = n & 2047; row = (size_t)(256 * (nn >> 7) + 128 * half + (nn & 127)); } \
            if (mcur.f8) { _Pragma("unroll") for (int i = 0; i < 8; ++i) x[i] *= 64.0f; __builtin_nontemporal_store(pack8_fp8(x), (GAS u32x2*)(mcur.dst + row * mcur.ldd + 8 * c)); } \
            else *(GAS v4u*)(mcur.dst + row * mcur.ldd + 16 * c) = pack8(x); } } while (0)
    volatile LAS int* qs = (volatile LAS int*)(F.lds + MISC_OFF) + 16;
    const int NP = (hi - lo) >> 1;
    __syncthreads();
    if (F.tid == 0) { qs[0] = (int)xb_add(Q, 1u); qs[1] = (int)xb_add(Q, 1u); }
    __syncthreads();
    int pc = qs[0], pn = qs[1], it = 0;
    f32x4 rgA[8], rgB[8];
    Mac mA = decode(lo + 2 * (pc < NP ? pc : 0)), mB = decode(lo + 2 * (pc < NP ? pc : 0) + 1);
    if (pc < NP) { P0_LOAD(rgA, mA); P0_LOAD(rgB, mB); }
    while (pc < NP) {
        int nx = 0; if (F.tid == 0) nx = (int)xb_add(Q, 1u);
        P0_STEP(rgA, mA, pn < NP, lo + 2 * pn, 0);
        if (F.tid == 0) qs[it & 1] = nx;
        P0_STEP(rgB, mB, pn < NP, lo + 2 * pn + 1, 1);
        pc = pn; pn = qs[it & 1]; ++it;
    }
#undef P0_LOAD
#undef P0_STEP
    __syncthreads();
}

__device__ __forceinline__ void p0_prologue(const Args& a, const Ctx& F) {
    unsigned char* ws = a.ws;
    const int gtid = F.vcu * 512 + F.tid, NT_ = F.G * 512;
    { int* STOK = (int*)(ws + WS_STOK); for (int r = gtid; r < 32 * 8192; r += NT_) STOK[r] = -1; }
    { const float* tab = a.in[19]; float* lb = (float*)(ws + WS_LB);
      for (int i = gtid; i < 2048; i += NT_) { const int dir = i >> 10, c = i & 1023; lb[i] = 1.0f / (1.0f + expf(tab[dir * 2048 + 1024 + c] - tab[dir * 2048 + c])); } }
    { const float* wr = a.in[13]; bf16_t* WRT = (bf16_t*)(ws + WS_WRT);
      for (int i = gtid; i < 32 * D; i += NT_) { const int e = i >> 11, k = i & 2047; const float w = wr[(size_t)k * 32 + e]; const bf16_t hi = f2bf(w); WRT[i] = hi; WRT[32 * D + i] = f2bf(w - bf2f(hi)); } }
    {
        LAS float* cs = (LAS float*)(F.lds);
        LAS float* red = (LAS float*)(F.lds + 16384);
        const float* c = a.in[1]; const float* w = a.in[2]; const float* bias = a.in[3]; float* ada = (float*)(ws + WS_ADA);
        bool have = false;
        for (int item = F.vcu; item < 192; item += F.G) {
            if (!have) { for (int i = F.tid; i < 4096; i += 512) { const float v = c[i]; cs[i] = v / (1.0f + expf(-v)); } __syncthreads(); have = true; }
            const int n0 = item * 64, cl = F.tid & 15, kg = F.tid >> 4;
            f32x4 a0 = {0.f, 0.f, 0.f, 0.f}, a1 = {0.f, 0.f, 0.f, 0.f};
            for (int k = kg; k < D; k += 32) { const f32x4 wv = __builtin_nontemporal_load((const f32x4*)(w + (size_t)k * (6 * D) + n0 + cl * 4)); a0 += cs[k] * wv; a1 += cs[2048 + k] * wv; }
            LAS float* rp = red + (kg * 16 + cl) * 8;
            rp[0] = a0[0]; rp[1] = a0[1]; rp[2] = a0[2]; rp[3] = a0[3]; rp[4] = a1[0]; rp[5] = a1[1]; rp[6] = a1[2]; rp[7] = a1[3];
            __syncthreads();
            if (F.tid < 128) { const int b = F.tid >> 6, col = F.tid & 63; float s = 0.f;
                for (int g = 0; g < 32; ++g) s += red[(g * 16 + (col >> 2)) * 8 + b * 4 + (col & 3)];
                ada[b * 6 * D + n0 + col] = s + bias[n0 + col]; }
            __syncthreads();
        }
        __syncthreads();
    }
    convert_stream(a, F, (unsigned*)(ws + WS_CTL) + CW_Q0, M_EXP + M_O + M_BR + M_BA, NMAC);
}

__device__ __forceinline__ void p1_norm_mod(const Args& a, const Ctx& F) {
    const float* x = a.in[0]; const float* g = a.in[4]; const float* ada = (const float*)(a.ws + WS_ADA); bf16_t* XN = (bf16_t*)(a.ws + WS_XN);
    const int gw = F.vcu * NWAVES + F.wave, NGW = F.G * NWAVES;
    for (int t = gw; t < T; t += NGW) {
        const int b = t / SEQ; const float* ad = ada + b * 6 * D; const float* xr = x + (size_t)t * D;
        float v[32]; float ss = 0.f;
#pragma unroll
        for (int j = 0; j < 4; ++j) { const f32x4 p = *(const f32x4*)(xr + F.lane * 8 + 512 * j), q = *(const f32x4*)(xr + F.lane * 8 + 512 * j + 4);
#pragma unroll
            for (int i = 0; i < 4; ++i) { v[8 * j + i] = p[i]; v[8 * j + 4 + i] = q[i]; ss += p[i] * p[i] + q[i] * q[i]; } }
        const float rs = rsqrtf(wave_sum(ss) * (1.0f / D) + RMS_EPS);
#pragma unroll
        for (int j = 0; j < 4; ++j) { const int c = F.lane * 8 + 512 * j; float o[8];
#pragma unroll
            for (int i = 0; i < 8; ++i) o[i] = v[8 * j + i] * rs * g[c + i] * (1.0f + ad[D + c + i]) + ad[c + i];
            st_bf16x8(XN + (size_t)t * D + c, o); }
    }
}

constexpr int PL_OFF = LDSCTL_OFF + 4096;
__device__ __forceinline__ void p6_post(const Args& a, const Ctx& F) {
    const float* x = a.in[0]; const bf16_t* Y = (const bf16_t*)(a.ws + WS_Y); const float* g_post = a.in[5]; const float* g_pre2 = a.in[6];
    const float* ada = (const float*)(a.ws + WS_ADA); const float* b_router = a.in[14];
    bf16_t* X1 = (bf16_t*)(a.ws + WS_XN)  ; unsigned char* H2F8 = a.ws + WS_XS; const bf16_t* WRT = (const bf16_t*)(a.ws + WS_WRT);
    int* POS = (int*)(a.ws + WS_POS); int* STOK = (int*)(a.ws + WS_STOK); float* SW = (float*)(a.ws + WS_SW); unsigned* ctl = (unsigned*)(a.ws + WS_CTL);
    LAS unsigned char* HH = F.lds; LAS unsigned char* HL = F.lds + 65536;
    LAS float* PL = (LAS float*)(F.lds + PL_OFF);
    const int RPW = T / F.G, t00 = F.vcu * RPW, lane = F.lane, g = lane >> 4, li = lane & 15;
    for (int hb = 0; hb < RPW / 16; ++hb) {
        for (int rr = F.wave; rr < 16; rr += NWAVES) {
            const int t = t00 + 16 * hb + rr, b = t / SEQ; const float* ad = ada + b * 6 * D;
            float v[32]; float ss = 0.f;
#pragma unroll
            for (int j = 0; j < 4; ++j) { const v4u u = *(const v4u*)(Y + (size_t)t * D + lane * 8 + 512 * j);
                v[8 * j] = bflo(u.x); v[8 * j + 1] = bfhi(u.x); v[8 * j + 2] = bflo(u.y); v[8 * j + 3] = bfhi(u.y); v[8 * j + 4] = bflo(u.z); v[8 * j + 5] = bfhi(u.z); v[8 * j + 6] = bflo(u.w); v[8 * j + 7] = bfhi(u.w);
#pragma unroll
                for (int i = 0; i < 8; ++i) ss += v[8 * j + i] * v[8 * j + i]; }
            const float rs = rsqrtf(wave_sum(ss) * (1.0f / D) + RMS_EPS);
            float s2 = 0.f;
#pragma unroll
            for (int j = 0; j < 4; ++j) { const int c = lane * 8 + 512 * j; const float* xr = x + (size_t)t * D + c; const f32x4 p = *(const f32x4*)xr, q = *(const f32x4*)(xr + 4);
                float o[8];
#pragma unroll
                for (int i = 0; i < 8; ++i) { const float xv = i < 4 ? p[i & 3] : q[i & 3]; o[i] = xv + ad[2 * D + c + i] * (v[8 * j + i] * rs * g_post[c + i]); v[8 * j + i] = o[i]; s2 += o[i] * o[i]; }
                __builtin_nontemporal_store(pack8(o), (v4u*)(X1 + (size_t)t * D + c)); }
            const float rs2 = rsqrtf(wave_sum(s2) * (1.0f / D) + RMS_EPS);
#pragma unroll
            for (int j = 0; j < 4; ++j) { const int c = lane * 8 + 512 * j; float o[8], lo[8];
#pragma unroll
                for (int i = 0; i < 8; ++i) o[i] = v[8 * j + i] * rs2 * g_pre2[c + i] * (1.0f + ad[4 * D + c + i]) + ad[3 * D + c + i];
                const v4u hi = pack8(o);
                lo[0] = o[0] - bflo(hi.x); lo[1] = o[1] - bfhi(hi.x); lo[2] = o[2] - bflo(hi.y); lo[3] = o[3] - bfhi(hi.y); lo[4] = o[4] - bflo(hi.z); lo[5] = o[5] - bfhi(hi.z); lo[6] = o[6] - bflo(hi.w); lo[7] = o[7] - bfhi(hi.w);
                const int off = rr * 4096 + (((lane + 64 * j) ^ rr) << 4);
                *(LAS v4u*)(HH + off) = hi; *(LAS v4u*)(HL + off) = pack8(lo); *(u32x2*)(H2F8 + (size_t)t * D + c) = pack8_fp8(o); }
        }
        __syncthreads();
        if (F.wave < 4) {
            const int kq = F.wave;
            f32x4 acc[2] = {{0.f, 0.f, 0.f, 0.f}, {0.f, 0.f, 0.f, 0.f}};
#pragma unroll 4
            for (int ks = 0; ks < 16; ++ks) {
                const int off = li * 4096 + (((kq * 64 + 4 * ks + g) ^ li) << 4);
                const bfx8 ah = *(const LAS bfx8*)(HH + off), al = *(const LAS bfx8*)(HL + off);
#pragma unroll
                for (int eb = 0; eb < 2; ++eb) { const size_t wo = (size_t)(16 * eb + li) * D + kq * 512 + 32 * ks + 8 * g;
                    const bfx8 bh = *(const bfx8*)(WRT + wo), bl = *(const bfx8*)(WRT + 32 * D + wo);
                    acc[eb] = MFMA16(ah, bh, acc[eb]); acc[eb] = MFMA16(ah, bl, acc[eb]); acc[eb] = MFMA16(al, bh, acc[eb]); }
            }
#pragma unroll
            for (int eb = 0; eb < 2; ++eb)
#pragma unroll
                for (int e = 0; e < 4; ++e) PL[(((hb & 1) * 4 + kq) * 16 + 4 * g + e) * 32 + 16 * eb + li] = acc[eb][e];
        }
        __syncthreads();
        if (!((hb & 1) || hb == RPW / 16 - 1)) continue;
      if (F.wave == 0) {
        volatile LAS unsigned* lc = (volatile LAS unsigned*)(F.lds + LDSCTL_OFF + 3072);
        const int r0 = (hb & ~1) * 16, nr = (hb + 1) * 16 - r0, r = r0 + lane; const bool act = lane < nr;
        if (lane < 32) lc[lane] = 0u;
        __builtin_amdgcn_wave_barrier();
        int idx[4] = {0, 0, 0, 0}; float wgt[4] = {0.f, 0.f, 0.f, 0.f}; unsigned lr[4] = {0u, 0u, 0u, 0u};
        if (act) {
            const int hq = (r >> 4) & 1, rr = r & 15;
            float lv[32];
#pragma unroll
            for (int e = 0; e < 32; ++e) lv[e] = ((PL[((hq * 4 + 0) * 16 + rr) * 32 + e] + PL[((hq * 4 + 1) * 16 + rr) * 32 + e]) + (PL[((hq * 4 + 2) * 16 + rr) * 32 + e] + PL[((hq * 4 + 3) * 16 + rr) * 32 + e])) + b_router[e];
            float val[4];
#pragma unroll
            for (int k = 0; k < 4; ++k) { float bv = -3.0e38f; int bi = 0;
#pragma unroll
                for (int e = 0; e < 32; ++e) { const bool gt = lv[e] > bv; bv = gt ? lv[e] : bv; bi = gt ? e : bi; }
#pragma unroll
                for (int e = 0; e < 32; ++e) lv[e] = (e == bi) ? -3.0e38f : lv[e];
                idx[k] = bi; val[k] = bv; }
            float den = 0.f;
#pragma unroll
            for (int k = 0; k < 4; ++k) { wgt[k] = expf(val[k] - val[0]); den += wgt[k]; }
#pragma unroll
            for (int k = 0; k < 4; ++k) { wgt[k] /= den; lr[k] = __hip_atomic_fetch_add((LAS unsigned*)lc + idx[k], 1u, __ATOMIC_RELAXED, __HIP_MEMORY_SCOPE_WORKGROUP); }
        }
        __builtin_amdgcn_wave_barrier();
        if (lane < 32) { const unsigned c = lc[lane]; lc[32 + lane] = c ? xb_add(&ctl[CW_CNT + 64 * lane], c) : 0u; }
        __builtin_amdgcn_wave_barrier();
        if (act) { const int t = t00 + r;
#pragma unroll
            for (int k = 0; k < 4; ++k) { const int sl = idx[k] * 8192 + (int)(lc[32 + idx[k]] + lr[k]); POS[t * 4 + k] = sl; STOK[sl] = t; SW[sl] = wgt[k]; } }
      }
      __syncthreads();
    }
}

__device__ __forceinline__ void build_rt(const Args& a, const Ctx& F) {
    LAS int* rt = (LAS int*)(F.lds + RT_OFF);
    if (F.tid < 64) { unsigned* ctl = (unsigned*)(a.ws + WS_CTL); const int e = F.tid;
        const int cnt = e < 32 ? (int)xb_ld(&ctl[CW_CNT + 64 * e]) : 0, tiles = (cnt + 255) >> 8;
        int incl = tiles;
#pragma unroll
        for (int o = 1; o < 32; o <<= 1) { const int v = __shfl_up(incl, o); incl += (e >= o) ? v : 0; }
        if (e < 32) { rt[e] = incl - tiles; rt[40 + e] = cnt; }
        if (e == 31) rt[32] = incl; }
    __syncthreads();
}
__device__ __forceinline__ void build_units(const Ctx& F, int nct) {
    const LAS int* rt = (const LAS int*)(F.lds + RT_OFF); LAS int* ul = (LAS int*)(F.lds + UL_OFF);
    const int total = nct * rt[32];
    if (F.tid < 96) { const int n = F.tid, L = F.vcu + n * F.G;
        if (L < total) { int e = 0; while (e < 31 && nct * rt[e + 1] <= L) ++e;
            const int l = L - nct * rt[e], nrt = rt[e + 1] - rt[e], ct = l / nrt, r = l % nrt;
            const int valid = rt[40 + e] - 256 * r;
            ul[4 + 4 * n] = rt[e] + r; ul[4 + 4 * n + 1] = ct; ul[4 + 4 * n + 2] = e * nct + ct; ul[4 + 4 * n + 3] = e | (valid <= 128 ? 256 : 0) | (r << 12); }
        if (n == 0) { const int cnt = total > F.vcu ? (total - F.vcu + F.G - 1) / F.G : 0; ul[0] = cnt < 96 ? cnt : 96; } }
    __syncthreads();
}
__device__ __forceinline__ void p11_final(const Args& a, const Ctx& F) {
    const bf16_t* X1 = (const bf16_t*)(a.ws + WS_XN); const bf16_t* YB = (const bf16_t*)(a.ws + WS_YB); const int* POS = (const int*)(a.ws + WS_POS); const float* g = a.in[7];
    const float* ada = (const float*)(a.ws + WS_ADA); float* out = a.out;
    build_rt(a, F); const LAS int* rt = (const LAS int*)(F.lds + RT_OFF);
    const int gw = F.vcu * NWAVES + F.wave, NGW = F.G * NWAVES;
    for (int t = gw; t < T; t += NGW) {
        const int b = t / SEQ; const float* ad = ada + b * 6 * D + 5 * D;
        float y[32];
#pragma unroll
        for (int i = 0; i < 32; ++i) y[i] = 0.f;
#pragma unroll
        for (int k = 0; k < 4; ++k) { const int sl = POS[t * 4 + k]; const int r = rt[sl >> 13] * 256 + (sl & 8191);
#pragma unroll
            for (int j = 0; j < 4; ++j) { const v4u u = *(const v4u*)(YB + (size_t)r * D + F.lane * 8 + 512 * j);
                y[8 * j] += bflo(u.x); y[8 * j + 1] += bfhi(u.x); y[8 * j + 2] += bflo(u.y); y[8 * j + 3] += bfhi(u.y); y[8 * j + 4] += bflo(u.z); y[8 * j + 5] += bfhi(u.z); y[8 * j + 6] += bflo(u.w); y[8 * j + 7] += bfhi(u.w); } }
        float ss = 0.f;
#pragma unroll
        for (int i = 0; i < 32; ++i) ss += y[i] * y[i];
        const float rs = rsqrtf(wave_sum(ss) * (1.0f / D) + RMS_EPS);
#pragma unroll
        for (int j = 0; j < 4; ++j) { const int c = F.lane * 8 + 512 * j; const v4u xu = *(const v4u*)(X1 + (size_t)t * D + c); const float xv[8] = {bflo(xu.x), bfhi(xu.x), bflo(xu.y), bfhi(xu.y), bflo(xu.z), bfhi(xu.z), bflo(xu.w), bfhi(xu.w)}; float o[8];
#pragma unroll
            for (int i = 0; i < 8; ++i) o[i] = xv[i] + ad[c + i] * (y[8 * j + i] * rs * g[c + i]);
            st_f32x8_nt(out + (size_t)t * D + c, o); }
    }
}


typedef short s16x4 __attribute__((ext_vector_type(4)));
typedef short v4i16_t __attribute__((ext_vector_type(4)));
__device__ __forceinline__ s16x4 lds_tr(const LAS unsigned char* p) { return __builtin_bit_cast(s16x4, __builtin_amdgcn_ds_read_tr16_b64_v4i16((LAS v4i16_t*)p)); }
__device__ __forceinline__ bfx8 cat4(s16x4 a, s16x4 b) { return (bfx8){a[0], a[1], a[2], a[3], b[0], b[1], b[2], b[3]}; }
__device__ __forceinline__ bfx8 pack8f(const float (&x)[8]) { const v4u w = pack8(x); return __builtin_bit_cast(bfx8, w); }
constexpr int TP = 288;
constexpr int BP = 132;
constexpr size_t WS_ST = (size_t)3072 * MiB;
constexpr size_t WS_DEC = WS_ST + 64 * MiB;

__device__ __forceinline__ void p3_passA(const Args& a, const Ctx& F) {
    LAS unsigned char* VT = F.lds; LAS unsigned char* KF = F.lds + 18432; LAS unsigned char* KB = F.lds + 36864; LAS float* TOT = (LAS float*)(F.lds + 55296); LAS unsigned char* SLF = F.lds + 65536;
    const bf16_t* VR = (const bf16_t*)(a.ws + WS_VR); bf16_t* ST = (bf16_t*)(a.ws + WS_ST); float* DEC = (float*)(a.ws + WS_DEC);
    const int tid = F.tid, lane = F.lane, g = lane >> 4, q = (lane & 15) >> 2, p = lane & 3;
    v4u pv[2], pf[2], pb[2];
    auto fetchA = [&](int unit) {
        const int b = unit >> 9, h = (unit >> 6) & 7, c = unit & 63, row0 = b * SEQ + c * 64;
        { const int r = tid >> 3, sg = tid & 7; const bf16_t* src = VR + (size_t)(row0 + r) * 1024 + h * 128 + sg * 16; pv[0] = *(const v4u*)src; pv[1] = *(const v4u*)(src + 8); }
#pragma unroll
        for (int i = 0; i < 2; ++i) { const int idx = tid + 512 * i, row = idx >> 4, ch = idx & 15; const size_t go = (size_t)(row0 + row) * 1024 + h * 128 + ch * 8;
            pf[i] = *(const v4u*)((const _Float16*)(a.ws + WS_LFF) + go); pb[i] = *(const v4u*)((const _Float16*)(a.ws + WS_LFB) + go); }
    };
    if (F.vcu < 1024) fetchA(F.vcu);
    for (int unit = F.vcu; unit < 1024; unit += F.G) {
        const int b = unit >> 9, h = (unit >> 6) & 7, c = unit & 63, row0 = b * SEQ + c * 64;
        { const int r = tid >> 3, sg = tid & 7; *(LAS v4u*)(VT + r * TP + sg * 32) = pv[0]; *(LAS v4u*)(VT + r * TP + sg * 32 + 16) = pv[1]; }
#pragma unroll
        for (int i = 0; i < 2; ++i) { const int idx = tid + 512 * i, row = idx >> 4, ch = idx & 15;
            *(LAS v4u*)(SLF + (row * 128 + ch * 8) * 2) = pf[i]; *(LAS v4u*)(SLF + 16384 + (row * 128 + ch * 8) * 2) = pb[i]; }
        __syncthreads();
        if (unit + F.G < 1024) fetchA(unit + F.G);
        const int dir = tid >> 8, half = (tid >> 7) & 1, d = tid & 127;
        const LAS _Float16* LF = (const LAS _Float16*)(SLF + dir * 16384) + (half * 32) * 128 + d;
        float lf[32]; float s = 0.f;
#pragma unroll
        for (int j = 0; j < 32; ++j) { lf[j] = (float)LF[j * 128]; s += lf[j]; }
        TOT[(dir * 2 + half) * 128 + d] = s;
        __syncthreads();
        const float other = TOT[(dir * 2 + (half ^ 1)) * 128 + d];
        if (dir == 0) { float suf = half == 0 ? other : 0.f;
#pragma unroll
            for (int j = 31; j >= 0; --j) { const float kt = (1.0f - __expf(lf[j])) * __expf(suf); *(LAS bf16_t*)(KF + (half * 32 + j) * TP + d * 2) = f2bf(kt); suf += lf[j]; } }
        else { float pre = half == 1 ? other : 0.f;
#pragma unroll
            for (int j = 0; j < 32; ++j) { const float kt = (1.0f - __expf(lf[j])) * __expf(pre); *(LAS bf16_t*)(KB + (half * 32 + j) * TP + d * 2) = f2bf(kt); pre += lf[j]; } }
        const int chain_t = (b * 8 + h) * 2 + dir;
        if (half == 0) DEC[(size_t)(chain_t * 64 + c) * 128 + d] = __expf(s + other);
        __syncthreads();
        const int wdir = F.wave >> 2, db0 = (F.wave & 3) * 2; const LAS unsigned char* KT = wdir ? KB : KF;
        const int chain_w = (b * 8 + h) * 2 + wdir; bf16_t* dst = ST + (size_t)(chain_w * 64 + c) * 16384;
        bfx8 af[2][2];
#pragma unroll
        for (int dbi = 0; dbi < 2; ++dbi)
#pragma unroll
            for (int kk = 0; kk < 2; ++kk) { const LAS unsigned char* ap = KT + (32 * kk + 8 * g + q) * TP + (16 * (db0 + dbi) + 4 * p) * 2; af[dbi][kk] = cat4(lds_tr(ap), lds_tr(ap + 4 * TP)); }
#pragma unroll
        for (int vb = 0; vb < 8; ++vb) {
            bfx8 bf_[2];
#pragma unroll
            for (int kk = 0; kk < 2; ++kk) { const LAS unsigned char* bp = VT + (32 * kk + 8 * g + q) * TP + (16 * vb + 4 * p) * 2; bf_[kk] = cat4(lds_tr(bp), lds_tr(bp + 4 * TP)); }
#pragma unroll
            for (int dbi = 0; dbi < 2; ++dbi) { f32x4 acc = {0.f, 0.f, 0.f, 0.f};
                acc = MFMA16(af[dbi][0], bf_[0], acc); acc = MFMA16(af[dbi][1], bf_[1], acc);
                uint2 w; w.x = pk2(acc[0], acc[1]); w.y = pk2(acc[2], acc[3]);
                *(uint2*)(dst + (size_t)(16 * vb + (lane & 15)) * 128 + 16 * (db0 + dbi) + 4 * g) = w; }
        }
        __syncthreads();
    }
}
__device__ __forceinline__ void p3_passB(const Args& a, const Ctx& F) {
    bf16_t* ST = (bf16_t*)(a.ws + WS_ST); const float* DEC = (const float*)(a.ws + WS_DEC);
    const int per = ((32 * 2048 + F.G - 1) / F.G + 63) & ~63;
    for (int k = F.tid; k < per; k += NWAVES * 64) {
        const int gid = F.vcu * per + k; if (gid >= 32 * 2048) break;
        const int chain = gid >> 11, rem = gid & 2047, d8 = rem & 15, dir = chain & 1;
        float S[8] = {0.f, 0.f, 0.f, 0.f, 0.f, 0.f, 0.f, 0.f};
        for (int s0 = 0; s0 < 64; s0 += 8) {
            v4u x[8]; f32x4 dc[8][2];
#pragma unroll
            for (int u = 0; u < 8; ++u) { const int n = dir ? 63 - (s0 + u) : s0 + u; x[u] = *(const v4u*)(ST + (size_t)(chain * 64 + n) * 16384 + rem * 8);
                const float* dp = DEC + (size_t)(chain * 64 + n) * 128 + d8 * 8; dc[u][0] = *(const f32x4*)dp; dc[u][1] = *(const f32x4*)(dp + 4); }
#pragma unroll
            for (int u = 0; u < 8; ++u) { const int n = dir ? 63 - (s0 + u) : s0 + u;
                *(v4u*)(ST + (size_t)(chain * 64 + n) * 16384 + rem * 8) = pack8(S);
                S[0] = dc[u][0][0] * S[0] + bflo(x[u].x); S[1] = dc[u][0][1] * S[1] + bfhi(x[u].x); S[2] = dc[u][0][2] * S[2] + bflo(x[u].y); S[3] = dc[u][0][3] * S[3] + bfhi(x[u].y);
                S[4] = dc[u][1][0] * S[4] + bflo(x[u].z); S[5] = dc[u][1][1] * S[5] + bfhi(x[u].z); S[6] = dc[u][1][2] * S[6] + bflo(x[u].w); S[7] = dc[u][1][3] * S[7] + bfhi(x[u].w); }
        }
    }
}
__device__ __forceinline__ void p3_passC(const Args& a, const Ctx& F) {
    LAS unsigned char* VT = F.lds; LAS unsigned char* QE = F.lds + 18432; LAS unsigned char* K0 = F.lds + 3 * 18432;
    LAS float* DJ = (LAS float*)(F.lds + 5 * 18432); LAS float* OX = DJ + 1024;
    LAS unsigned char* SLF = (LAS unsigned char*)OX; LAS unsigned char* SQ = F.lds + LDSCTL_OFF + 4096;
    static_assert(4 * 16 * BP * 4 >= 32768 && LDSCTL_OFF + 4096 + 16384 <= LDS_BYTES, "pass C staging");
    static_assert(5 * 18432 + 4096 + 4 * 16 * BP * 4 <= RING_BYTES, "pass C LDS map");
    const bf16_t* QR = (const bf16_t*)(a.ws + WS_QR); const bf16_t* VR = (const bf16_t*)(a.ws + WS_VR); const bf16_t* ST = (const bf16_t*)(a.ws + WS_ST);
    const bf16_t* GO = (const bf16_t*)(a.ws + WS_GO); const float* g_out = a.in[9]; bf16_t* OREC = (bf16_t*)(a.ws + WS_OREC);
    const int tid = F.tid, lane = F.lane, g = lane >> 4, li = lane & 15, q = li >> 2, p = lane & 3;
    v4u cv[2], cf[2], cb[2], cq[2];
    auto fetchC = [&](int unit) {
        const int b = unit >> 9, h = (unit >> 6) & 7, c = unit & 63, row0 = b * SEQ + c * 64;
        { const int r = tid >> 3, sg = tid & 7; const size_t so = (size_t)(row0 + r) * 1024 + h * 128 + sg * 16; cv[0] = *(const v4u*)(VR + so); cv[1] = *(const v4u*)(VR + so + 8); }
#pragma unroll
        for (int i = 0; i < 2; ++i) { const int idx = tid + 512 * i, row = idx >> 4, ch = idx & 15; const size_t go = (size_t)(row0 + row) * 1024 + h * 128 + ch * 8;
            cf[i] = *(const v4u*)((const _Float16*)(a.ws + WS_LFF) + go); cb[i] = *(const v4u*)((const _Float16*)(a.ws + WS_LFB) + go); cq[i] = *(const v4u*)(QR + go); }
    };
    if (F.vcu < 1024) fetchC(F.vcu);
    for (int unit = F.vcu; unit < 1024; unit += F.G) {
        const int b = unit >> 9, h = (unit >> 6) & 7, c = unit & 63, row0 = b * SEQ + c * 64;
        { const int r = tid >> 3, sg = tid & 7; *(LAS v4u*)(VT + r * TP + sg * 32) = cv[0]; *(LAS v4u*)(VT + r * TP + sg * 32 + 16) = cv[1]; }
#pragma unroll
        for (int i = 0; i < 2; ++i) { const int idx = tid + 512 * i, row = idx >> 4, ch = idx & 15; const int lo_ = (row * 128 + ch * 8) * 2;
            *(LAS v4u*)(SLF + lo_) = cf[i]; *(LAS v4u*)(SLF + 16384 + lo_) = cb[i]; *(LAS v4u*)(SQ + lo_) = cq[i]; }
        __syncthreads();
        {
            const int dir = tid >> 8, half = (tid >> 7) & 1, d = tid & 127;
            const LAS _Float16* LF = (const LAS _Float16*)(SLF + dir * 16384) + (half * 32) * 128 + d;
            const LAS bf16_t* Qp = (const LAS bf16_t*)SQ + (half * 32) * 128 + d;
            float lf[32], qv[32];
#pragma unroll
            for (int j = 0; j < 32; ++j) { lf[j] = (float)LF[j * 128]; qv[j] = bf2f(Qp[j * 128]); }
            LAS unsigned char* QEd = QE + dir * 18432; LAS unsigned char* K0d = K0 + dir * 18432;
#pragma unroll
            for (int bb = 0; bb < 2; ++bb) {
                float run = 0.f;
                if (dir == 0) {
#pragma unroll
                    for (int jj = 0; jj < 16; ++jj) { const int j = 16 * bb + jj; run += lf[j]; const float e = __expf(run);
                        *(LAS bf16_t*)(QEd + (half * 32 + j) * TP + d * 2) = f2bf(qv[j] * e);
                        *(LAS bf16_t*)(K0d + (half * 32 + j) * TP + d * 2) = f2bf((1.0f - __expf(lf[j])) * __expf(fminf(-run, 60.0f))); }
                } else {
#pragma unroll
                    for (int jj = 15; jj >= 0; --jj) { const int j = 16 * bb + jj; run += lf[j]; const float e = __expf(run);
                        *(LAS bf16_t*)(QEd + (half * 32 + j) * TP + d * 2) = f2bf(qv[j] * e);
                        *(LAS bf16_t*)(K0d + (half * 32 + j) * TP + d * 2) = f2bf((1.0f - __expf(lf[j])) * __expf(fminf(-run, 60.0f))); }
                }
                DJ[(dir * 4 + half * 2 + bb) * 128 + d] = __expf(run);
            }
        }
        __syncthreads();
        if (unit + F.G < 1024) fetchC(unit + F.G);
        const int I = F.wave & 3, wdir = F.wave >> 2;
        const LAS unsigned char* QEd = QE + wdir * 18432; const LAS unsigned char* K0d = K0 + wdir * 18432; const LAS float* DJd = DJ + wdir * 512;
        const int chain = (b * 8 + h) * 2 + wdir; const bf16_t* Sp = ST + (size_t)(chain * 64 + c) * 16384;
        float qf[4][8];
#pragma unroll
        for (int ks = 0; ks < 4; ++ks) { const bfx8 x = *(const LAS bfx8*)(QEd + (16 * I + li) * TP + (32 * ks + 8 * g) * 2);
#pragma unroll
            for (int j = 0; j < 8; ++j) qf[ks][j] = bf2f((bf16_t)x[j]); }
        f32x4 pt[4], o[8];
#pragma unroll
        for (int j = 0; j < 4; ++j) pt[j] = (f32x4){0.f, 0.f, 0.f, 0.f};
#pragma unroll
        for (int j = 0; j < 8; ++j) o[j] = (f32x4){0.f, 0.f, 0.f, 0.f};
#pragma unroll
        for (int step = 0; step < 4; ++step) {
            const int J = wdir ? I + step : I - step;
            if (J >= 0 && J < 4) {
                if (step > 0) {
                    const int Jd = J;
#pragma unroll
                    for (int ks = 0; ks < 4; ++ks) {
#pragma unroll
                        for (int hh = 0; hh < 2; ++hh) { const f32x4 dv = *(const LAS f32x4*)(DJd + Jd * 128 + 32 * ks + 8 * g + 4 * hh);
#pragma unroll
                            for (int j = 0; j < 4; ++j) qf[ks][4 * hh + j] *= dv[j]; } }
                }
                f32x4 acc = {0.f, 0.f, 0.f, 0.f};
#pragma unroll
                for (int ks = 0; ks < 4; ++ks) acc = MFMA16(*(const LAS bfx8*)(K0d + (16 * J + li) * TP + (32 * ks + 8 * g) * 2), pack8f(qf[ks]), acc);
                if (step == 0) {
#pragma unroll
                    for (int e = 0; e < 4; ++e) { const int jj = 4 * g + e; const bool keep = wdir ? (jj >= li) : (jj <= li); acc[e] = keep ? acc[e] : 0.f; } }
                pt[J] = acc;
            }
        }
#pragma unroll
        for (int ks = 0; ks < 4; ++ks) { const bfx8 qa = pack8f(qf[ks]);
#pragma unroll
            for (int vb = 0; vb < 8; ++vb) { const bfx8 sf = *(const bfx8*)(Sp + (size_t)(16 * vb + li) * 128 + 32 * ks + 8 * g); o[vb] = MFMA16(qa, sf, o[vb]); } }
#pragma unroll
        for (int kk = 0; kk < 2; ++kk) {
            float pe[8];
#pragma unroll
            for (int e = 0; e < 4; ++e) { pe[e] = pt[2 * kk][e]; pe[4 + e] = pt[2 * kk + 1][e]; }
            const bfx8 pa = pack8f(pe);
#pragma unroll
            for (int vb = 0; vb < 8; ++vb) { const LAS unsigned char* bp = VT + (32 * kk + 4 * g + q) * TP + (16 * vb + 4 * p) * 2;
                o[vb] = MFMA16(pa, cat4(lds_tr(bp), lds_tr(bp + 16 * TP)), o[vb]); }
        }
        v4u gov[2];
#pragma unroll
        for (int i = 0; i < 2; ++i) { const int idx = tid + 512 * i; gov[i] = *(const v4u*)(GO + (size_t)(row0 + (idx >> 4)) * 1024 + h * 128 + (idx & 15) * 8); }
        if (wdir == 1) {
#pragma unroll
            for (int vb = 0; vb < 8; ++vb)
#pragma unroll
                for (int e = 0; e < 4; ++e) OX[(I * 16 + 4 * g + e) * BP + 16 * vb + li] = o[vb][e]; }
        __syncthreads();
        if (wdir == 0) {
            float ssq[4];
#pragma unroll
            for (int e = 0; e < 4; ++e) { float sacc = 0.f;
#pragma unroll
                for (int vb = 0; vb < 8; ++vb) { o[vb][e] += OX[(I * 16 + 4 * g + e) * BP + 16 * vb + li]; sacc += o[vb][e] * o[vb][e]; }
                sacc += __shfl_xor(sacc, 1); sacc += __shfl_xor(sacc, 2); sacc += __shfl_xor(sacc, 4); sacc += __shfl_xor(sacc, 8); ssq[e] = sacc; }
#pragma unroll
            for (int e = 0; e < 4; ++e) { const float rs = rsqrtf(ssq[e] * (1.0f / 128.0f) + RMS_EPS);
#pragma unroll
                for (int vb = 0; vb < 8; ++vb) OX[(I * 16 + 4 * g + e) * BP + 16 * vb + li] = o[vb][e] * rs; }
        }
        __syncthreads();
#pragma unroll
        for (int i = 0; i < 2; ++i) {
            const int idx = tid + 512 * i, rl = idx >> 4, c8 = (idx & 15) * 8;
            const f32x4 a0 = *(const LAS f32x4*)(OX + rl * BP + c8), a1 = *(const LAS f32x4*)(OX + rl * BP + c8 + 4);
            const f32x4 w0 = *(const f32x4*)(g_out + h * 128 + c8), w1 = *(const f32x4*)(g_out + h * 128 + c8 + 4);
            const v4u gu = gov[i];
            float x[8] = {a0[0] * w0[0] * bflo(gu.x), a0[1] * w0[1] * bfhi(gu.x), a0[2] * w0[2] * bflo(gu.y), a0[3] * w0[3] * bfhi(gu.y), a1[0] * w1[0] * bflo(gu.z), a1[1] * w1[1] * bfhi(gu.z), a1[2] * w1[2] * bflo(gu.w), a1[3] * w1[3] * bfhi(gu.w)};
            st_bf16x8(OREC + (size_t)(row0 + rl) * 1024 + h * 128 + c8, x);
        }
        __syncthreads();
    }
}
constexpr size_t WS_ATP = WS_DEC + 2 * MiB;
constexpr size_t WS_ATM = WS_ATP + 24 * MiB;
constexpr size_t WS_ATL = WS_ATM + 1 * MiB;
__device__ __forceinline__ void p3_attn(const Args& a, const Ctx& F) {
    LAS unsigned char* KT = F.lds; LAS unsigned char* VT = F.lds + 55296; LAS float* TB = (LAS float*)(F.lds + 55296 + 59904);
    const bf16_t* QA = (const bf16_t*)(a.ws + WS_QA); const bf16_t* KA = (const bf16_t*)(a.ws + WS_KA); const bf16_t* VA = (const bf16_t*)(a.ws + WS_VA);
    bf16_t* ATP = (bf16_t*)(a.ws + WS_ATP); float* ATM = (float*)(a.ws + WS_ATM); float* ATL = (float*)(a.ws + WS_ATL); const float* rel_bias = a.in[20];
    const int tid = F.tid, lane = F.lane, g = lane >> 4, li = lane & 15, q = li >> 2, p = lane & 3;
    v4u kx[6], vx[6]; bfx8 qn[4]; float tbv = 0.f;
    auto fetch = [&](int unit) {
        const int bh = unit >> 6, b = bh / 12, head = bh % 12, grp = head >> 2, dil = grp == 0 ? 1 : (grp == 1 ? 4 : 16);
        const int nqb = 64 / dil, u6 = unit & 63, r = u6 / nqb, qb = u6 % nqb, l0 = qb * 64, L = SEQ / dil;
        if (tid < 129) tbv = rel_bias[t5_bucket((tid - 64) * dil) * 12 + head];
#pragma unroll
        for (int it = 0; it < 6; ++it) { const int idx = tid + 512 * it, row = idx >> 4, ch = idx & 15, kl = l0 - 64 + row;
            kx[it] = (v4u){0u, 0u, 0u, 0u}; vx[it] = (v4u){0u, 0u, 0u, 0u};
            if (kl >= 0 && kl < L) { const size_t o = ((size_t)b * SEQ + (size_t)kl * dil + r) * DATT + head * 128 + ch * 8; kx[it] = *(const v4u*)(KA + o); vx[it] = *(const v4u*)(VA + o); } }
        const size_t tq = (size_t)b * SEQ + (size_t)(l0 + 16 * (F.wave & 3) + li) * dil + r;
#pragma unroll
        for (int ks = 0; ks < 4; ++ks) qn[ks] = *(const bfx8*)(QA + tq * DATT + head * 128 + 32 * ks + 8 * g);
    };
    if (F.vcu < 1536) fetch(F.vcu);
    for (int unit = F.vcu; unit < 1536; unit += F.G) {
        const int bh = unit >> 6, b = bh / 12, head = bh % 12, grp = head >> 2, slot = head & 3, dil = grp == 0 ? 1 : (grp == 1 ? 4 : 16);
        const int nqb = 64 / dil, u6 = unit & 63, r = u6 / nqb, qb = u6 % nqb, l0 = qb * 64, L = SEQ / dil;
        if (tid < 129) TB[tid] = tbv;
#pragma unroll
        for (int it = 0; it < 6; ++it) { const int idx = tid + 512 * it, row = idx >> 4, ch = idx & 15;
            *(LAS v4u*)(KT + row * TP + ch * 16) = kx[it]; *(LAS v4u*)(VT + row * TP + ch * 16) = vx[it]; }
        if (tid < 256) *(LAS v4u*)(VT + (192 + (tid >> 4)) * TP + (tid & 15) * 16) = (v4u){0u, 0u, 0u, 0u};
        __syncthreads();
        const int I = F.wave & 3, hv = F.wave >> 2;
        const size_t tokq = (size_t)b * SEQ + (size_t)(l0 + 16 * I + li) * dil + r;
        bfx8 qf[4];
#pragma unroll
        for (int ks = 0; ks < 4; ++ks) qf[ks] = qn[ks];
        if (unit + F.G < 1536) fetch(unit + F.G);
        f32x4 s[9]; float m = -1e30f;
#pragma unroll
        for (int Jr = 0; Jr < 9; ++Jr) {
            const int J = I + Jr; f32x4 acc = {0.f, 0.f, 0.f, 0.f};
#pragma unroll
            for (int ks = 0; ks < 4; ++ks) acc = MFMA16(*(const LAS bfx8*)(KT + (16 * J + li) * TP + (32 * ks + 8 * g) * 2), qf[ks], acc);
#pragma unroll
            for (int e = 0; e < 4; ++e) { const int rel = 16 * Jr + 4 * g + e - 64 - li, kl = l0 - 64 + 16 * J + 4 * g + e;
                const bool valid = rel >= -64 && rel <= 64 && kl >= 0 && kl < L;
                const int ti = rel + 64 < 0 ? 0 : (rel + 64 > 128 ? 128 : rel + 64);
                acc[e] = valid ? acc[e] + TB[ti] : -1e30f; m = fmaxf(m, acc[e]); }
            s[Jr] = acc;
        }
        m = fmaxf(m, __shfl_xor(m, 16)); m = fmaxf(m, __shfl_xor(m, 32));
        float lsum = 0.f;
#pragma unroll
        for (int Jr = 0; Jr < 9; ++Jr)
#pragma unroll
            for (int e = 0; e < 4; ++e) { const float pv = __expf(s[Jr][e] - m); s[Jr][e] = pv; lsum += pv; }
        lsum += __shfl_xor(lsum, 16); lsum += __shfl_xor(lsum, 32);
        f32x4 o[4];
#pragma unroll
        for (int vb = 0; vb < 4; ++vb) o[vb] = (f32x4){0.f, 0.f, 0.f, 0.f};
#pragma unroll
        for (int kk = 0; kk < 5; ++kk) {
            float pe[8];
#pragma unroll
            for (int e = 0; e < 4; ++e) { pe[e] = s[2 * kk][e]; pe[4 + e] = (2 * kk + 1 < 9) ? s[(2 * kk + 1 < 9) ? 2 * kk + 1 : 8][e] : 0.f; }
            const bfx8 pa = pack8f(pe);
#pragma unroll
            for (int vb = 0; vb < 4; ++vb) { const LAS unsigned char* bp = VT + (16 * (I + 2 * kk) + 4 * g + q) * TP + (64 * hv + 16 * vb + 4 * p) * 2;
                o[vb] = MFMA16(pa, cat4(lds_tr(bp), lds_tr(bp + 16 * TP)), o[vb]); }
        }
#pragma unroll
        for (int e = 0; e < 4; ++e) { const float lr = __shfl(lsum, 4 * g + e); const float inv = 1.0f / lr;
            const size_t tok = (size_t)b * SEQ + (size_t)(l0 + 16 * I + 4 * g + e) * dil + r;
#pragma unroll
            for (int vb = 0; vb < 4; ++vb) ATP[((size_t)grp * T + tok) * 512 + slot * 128 + 64 * hv + 16 * vb + li] = f2bf(o[vb][e] * inv); }
        if (g == 0 && hv == 0) { ATM[((size_t)grp * T + tokq) * 4 + slot] = m; ATL[((size_t)grp * T + tokq) * 4 + slot] = lsum; }
        __syncthreads();
    }
}
__device__ __forceinline__ void p3_attn_combine(const Args& a, const Ctx& F) {
    const bf16_t* ATP = (const bf16_t*)(a.ws + WS_ATP); const float* ATM = (const float*)(a.ws + WS_ATM); const float* ATL = (const float*)(a.ws + WS_ATL); bf16_t* OATT = (bf16_t*)(a.ws + WS_OATT);
    const int gw = F.vcu * NWAVES + F.wave, NGW = F.G * NWAVES, lane = F.lane, slot = lane >> 4;
    for (int t = gw; t < T; t += NGW) {
        float mg[3], lg[3];
#pragma unroll
        for (int gi = 0; gi < 3; ++gi) { mg[gi] = ATM[((size_t)gi * T + t) * 4 + slot]; lg[gi] = ATL[((size_t)gi * T + t) * 4 + slot]; }
        const float mx = fmaxf(mg[0], fmaxf(mg[1], mg[2])); float w[3], den = 0.f;
#pragma unroll
        for (int gi = 0; gi < 3; ++gi) { w[gi] = __expf(mg[gi] - mx) * lg[gi]; den += w[gi]; }
        float acc[8] = {0.f, 0.f, 0.f, 0.f, 0.f, 0.f, 0.f, 0.f};
#pragma unroll
        for (int gi = 0; gi < 3; ++gi) { const v4u x = *(const v4u*)(ATP + ((size_t)gi * T + t) * 512 + lane * 8); const float wn = w[gi] / den;
            acc[0] += wn * bflo(x.x); acc[1] += wn * bfhi(x.x); acc[2] += wn * bflo(x.y); acc[3] += wn * bfhi(x.y); acc[4] += wn * bflo(x.z); acc[5] += wn * bfhi(x.z); acc[6] += wn * bflo(x.w); acc[7] += wn * bfhi(x.w); }
        st_bf16x8(OATT + (size_t)t * DAO + lane * 8, acc);
    }
}

__global__ void __launch_bounds__(NWAVES * 64, 2) mega_fwd(Args args) {
    extern __shared__ __attribute__((aligned(16))) unsigned char lds[];
    Ctx F; F.lds = (LAS unsigned char*)lds; F.tid = threadIdx.x; F.lane = F.tid & 63; F.wave = __builtin_amdgcn_readfirstlane(F.tid >> 6);
    F.G = gridDim.x; { const int bx = blockIdx.x; F.vcu = (F.G % 8 == 0) ? (bx % 8) * (F.G / 8) + bx / 8 : bx; }
    unsigned char* ws = args.ws;
    for (int u = F.tid; u < (LDS_BYTES - LDSCTL_OFF) / 4; u += NWAVES * 64) ((LAS unsigned*)(F.lds + LDSCTL_OFF))[u] = 0u;
    __syncthreads();
    XcdBarrier bar = xcd_barrier_post((unsigned*)(ws + WS_CTL) + CW_BAR, (volatile LAS unsigned*)(F.lds + MISC_OFF) + 8, (unsigned)F.G);
    const int G1 = F.G - (F.G / 32) * CONV_PER_32; const bool conv = (int)blockIdx.x >= G1;
    XcdBarrier bar1 = bar;
    if (!conv) bar1 = xcd_barrier_post((unsigned*)(ws + WS_CTL) + CW_BAR + XCD_BAR_WORDS, (volatile LAS unsigned*)(F.lds + MISC_OFF) + 10, (unsigned)G1);
    const int lo = args.ph_lo, hi = args.ph_hi;
#define IN(k) (lo <= (k) && (k) < hi)
#define SEAM(k) do { if (IN(k) && IN((k) + 1)) xcd_barrier(bar); } while (0)
    unsigned char* wo = ws + (size_t)args.pad * 512 * MiB;
    ProjOut P; P.QR = (bf16_t*)(wo + WS_QR); P.VR = (bf16_t*)(wo + WS_VR); P.LFF = (float*)(wo + WS_LFF); P.LFB = (float*)(wo + WS_LFB); P.GO = (bf16_t*)(wo + WS_GO);
    P.QA = (bf16_t*)(wo + WS_QA); P.KA = (bf16_t*)(wo + WS_KA); P.VA = (bf16_t*)(wo + WS_VA); P.GR = (bf16_t*)(wo + WS_GR); P.GA = (bf16_t*)(wo + WS_GA); P.lb = (const float*)(ws + WS_LB);

    if (IN(0)) { p0_prologue(args, F); } SEAM(0);
    if (IN(1)) {
        if (!conv) {
            Ctx C = F; C.G = G1; { const int bx = blockIdx.x; C.vcu = (G1 % 8 == 0) ? (bx % 8) * (G1 / 8) + bx / 8 : bx; }
            Ctx Cr = C; Cr.vcu = G1 - 1 - C.vcu;
            p1_norm_mod(args, C); xcd_barrier(bar1);
            {
                pg8::Gemm g{(const bf16_t*)(ws + WS_XN), (const bf16_t*)(ws + WS_WIN_T), D, nullptr}; pg8::ProjOrder S; S.init(T, DIN, G1, (int)blockIdx.x);
                EpiProjT E{P}; pg8::gemm_phase<EpiProjT, pg8::ProjOrder, true, true>(F.lds, g, S, E);
            }
            xcd_barrier(bar1);
            p3_attn(args, C); p3_passA(args, Cr); xcd_barrier(bar1); p3_passB(args, C); p3_attn_combine(args, C); xcd_barrier(bar1); p3_passC(args, C);
        }
        convert_stream(args, F, (unsigned*)(ws + WS_CTL) + CW_Q1, -(M_O + M_BR + M_BA), M_GU);
    }
    SEAM(3);
    if (IN(4)) {
        { pg8::Gemm g{(const bf16_t*)(ws + WS_OREC), (const bf16_t*)(ws + WS_WBR_T), DREC, nullptr}; pg8::StaticOrder S; S.init(T, D, F.G, (int)blockIdx.x);
          EpiBf16T E{(bf16_t*)(ws + WS_YR), D}; pg8::gemm_phase<EpiBf16T, pg8::StaticOrder, true>(F.lds, g, S, E); }
        VM_WAIT(); __syncthreads();
        { pg8::Gemm g{(const bf16_t*)(ws + WS_OATT), (const bf16_t*)(ws + WS_WBA_T), DAO, nullptr}; pg8::StaticOrder S; S.init(T, D, F.G, (int)blockIdx.x);
          EpiMergeT E{(const bf16_t*)(ws + WS_YR), P.GR, P.GA, (bf16_t*)(ws + WS_MG)}; pg8::gemm_phase<EpiMergeT, pg8::StaticOrder, true>(F.lds, g, S, E); }
    } SEAM(4);
    if (IN(5)) {
        pg8::Gemm g{(const bf16_t*)(ws + WS_MG), (const bf16_t*)(ws + WS_WO_T), D, nullptr}; pg8::StaticOrder S; S.init(T, D, F.G, (int)blockIdx.x);
        EpiBf16T E{(bf16_t*)(ws + WS_Y), D}; pg8::gemm_phase<EpiBf16T, pg8::StaticOrder, true>(F.lds, g, S, E);
    } SEAM(5);
    if (IN(6)) { p6_post(args, F); } SEAM(6);
    if (IN(9)) {
        build_rt(args, F);
        int G9 = F.G;
        if (F.G % 8 == 0 && G1 < F.G) { const int nu = 16 * ((const LAS int*)(F.lds + RT_OFF))[32], R = (nu + G1 - 1) / G1; G9 = R > 0 ? ((nu + R - 1) / R + 7) & ~7 : G1; G9 = G9 < 128 ? 128 : G9 > G1 ? G1 : G9; }
        if ((int)blockIdx.x < G9) {
            Ctx C = F; C.G = G9; { const int bx = blockIdx.x; C.vcu = (G9 % 8 == 0) ? (bx % 8) * (G9 / 8) + bx / 8 : bx; }
            build_units(C, 16);
            pg8::ListOrder S{(const LAS int*)(F.lds + UL_OFF) + 4, ((const LAS int*)(F.lds + UL_OFF))[0]};
            pg8::Gemm g{(const bf16_t*)(ws + WS_XS), (const bf16_t*)(ws + WS_WGU_T), D, (const int*)(ws + WS_STOK)};
            EpiGateUpT E{args.in[16], ws + WS_ACT}; pg8::gemm_phase<EpiGateUpT, pg8::ListOrder, true, true, true, true>(F.lds, g, S, E);
        }
        VM_WAIT(); __syncthreads();
        convert_stream(args, F, (unsigned*)(ws + WS_CTL) + CW_Q2, M_GU, M_EXP);
    } SEAM(9);
    if (IN(10)) {
        build_rt(args, F); build_units(F, 8);
        pg8::ListOrder S{(const LAS int*)(F.lds + UL_OFF) + 4, ((const LAS int*)(F.lds + UL_OFF))[0]};
        pg8::Gemm g{(const bf16_t*)(ws + WS_ACT), (const bf16_t*)(ws + WS_WDN_T), DFF, nullptr};
        EpiDownT E{args.in[18], (const float*)(ws + WS_SW), (bf16_t*)(ws + WS_YB)}; pg8::gemm_phase<EpiDownT, pg8::ListOrder, true, true, false, true>(F.lds, g, S, E);
    } SEAM(10);
    if (IN(11)) { p11_final(args, F); }
#undef IN
#undef SEAM
}

static int g_grid = 0;
static void launch_mega(const Args& base, int lo, int hi, int li, hipStream_t stream) {
    Args a = base; a.ph_lo = lo; a.ph_hi = hi; a.li = li & 0xff; a.pad = li >> 8;
    hipLaunchKernelGGL(mega_fwd, dim3(g_grid), dim3(NWAVES * 64), LDS_BYTES, stream, a);
}
extern "C" void kernel_launch(void* const* d_in, const int* in_sizes, int n_in, void* d_out, int out_size, void* d_ws, size_t ws_size, hipStream_t stream) {
    if (n_in != 21 || ws_size < WS_TOP) { fprintf(stderr, "kernel_launch: unexpected inputs/workspace (%d, %zu)\n", n_in, ws_size); return; }
    if (g_grid == 0) {
        int dev = 0, cus = 0;
        if (hipGetDevice(&dev) != hipSuccess || hipDeviceGetAttribute(&cus, hipDeviceAttributeMultiprocessorCount, dev) != hipSuccess || cus <= 0) { g_grid = -1; return; }
        if (hipFuncSetAttribute((const void*)mega_fwd, hipFuncAttributeMaxDynamicSharedMemorySize, LDS_BYTES) != hipSuccess) { g_grid = -1; return; }
        int nb = 0;
        if (hipOccupancyMaxActiveBlocksPerMultiprocessor(&nb, (const void*)mega_fwd, NWAVES * 64, (size_t)LDS_BYTES) != hipSuccess || nb < 1) { g_grid = -1; return; }
        int gsel = 256; while (gsel > cus) gsel >>= 1;
        g_grid = gsel < 16 ? -1 : gsel;
    }
    if (g_grid < 0) return;
    unsigned char* ws = (unsigned char*)d_ws; float* out = (float*)d_out;
    Args base{}; for (int i = 0; i < 21; ++i) base.in[i] = (const float*)d_in[i]; base.out = out; base.ws = ws;

    (void)hipMemsetAsync(ws + WS_CTL, 0, 1 * MiB, stream);
    launch_mega(base, 0, 12, 0, stream);
}
```

```cpp
#include <hip/hip_runtime.h>
#include <cstdio>
#include <cstdint>

typedef unsigned short bf16_t;
constexpr int T = 8192, SEQ = 4096, D = 2048, DREC = 1024, DATT = 1536, DAO = 512, DIN = 13824, NE = 32, DFF = 2048;
constexpr int PMAX = 40960;
constexpr int NTMAX = PMAX / 256;
constexpr float RMS_EPS = 1e-6f;

constexpr size_t MiB = 1ull << 20;
constexpr size_t WS_CTL = 0;
constexpr size_t WS_ADA = 2 * MiB;
constexpr size_t WS_LB = WS_ADA + 128 * 1024;
constexpr size_t WS_POS = 3 * MiB;
constexpr size_t WS_STOK = 4 * MiB;
constexpr size_t WS_SW = 5 * MiB;
constexpr size_t WS_TILE = WS_SW + 256 * 1024;
constexpr size_t WS_XN = 8 * MiB;
constexpr size_t WS_QR = WS_XN + 32 * MiB;
constexpr size_t WS_VR = WS_QR + 16 * MiB;
constexpr size_t WS_LFF = WS_VR + 16 * MiB;
constexpr size_t WS_LFB = WS_LFF + 32 * MiB;
constexpr size_t WS_GO = WS_LFB + 32 * MiB;
constexpr size_t WS_QA = WS_GO + 16 * MiB;
constexpr size_t WS_KA = WS_QA + 24 * MiB;
constexpr size_t WS_VA = WS_KA + 24 * MiB;
constexpr size_t WS_GR = WS_VA + 24 * MiB;
constexpr size_t WS_GA = WS_GR + 32 * MiB;
constexpr size_t WS_OFB = WS_GA + 32 * MiB;
constexpr size_t WS_OREC = WS_OFB + 64 * MiB;
constexpr size_t WS_OATT = WS_OREC + 16 * MiB;
constexpr size_t WS_YR = WS_OATT + 8 * MiB;
constexpr size_t WS_MG = WS_YR + 64 * MiB;
constexpr size_t WS_Y = WS_MG + 32 * MiB;
constexpr size_t WS_H2 = WS_Y + 64 * MiB;
constexpr size_t WS_XS = WS_H2 + 32 * MiB;
constexpr size_t WS_ACT = WS_XS + 160 * MiB;
constexpr size_t WS_YB = WS_ACT + 160 * MiB;
constexpr size_t WS_WIN_T = WS_YB + 160 * MiB;
constexpr size_t WS_WBR_T = WS_WIN_T + 56 * MiB;
constexpr size_t WS_WBA_T = WS_WBR_T + 4 * MiB;
constexpr size_t WS_WO_T = WS_WBA_T + 4 * MiB;
constexpr size_t WS_WGU_T = WS_WO_T + 8 * MiB;
constexpr size_t WS_WDN_T = WS_WGU_T + 512 * MiB;
constexpr size_t WS_END = WS_WDN_T + 256 * MiB;
constexpr size_t WS_H2L = (size_t)3000 * MiB;
constexpr size_t WS_WRT = (size_t)3040 * MiB;
constexpr size_t WS_TOP = (size_t)3200 * MiB;
constexpr int CW_CNT = 1024;
constexpr int CW_CUR = 4096;

__device__ __forceinline__ float bf2f(bf16_t b) { return __uint_as_float(((unsigned)b) << 16); }
__device__ __forceinline__ bf16_t f2bf(float f) { unsigned u = __float_as_uint(f); u += 0x7fffu + ((u >> 16) & 1u); return (bf16_t)(u >> 16); }
__device__ __forceinline__ float wave_sum(float v) {
#pragma unroll
    for (int o = 1; o < 64; o <<= 1) v += __shfl_xor(v, o);
    return v;
}
struct ProjOut { bf16_t *QR, *VR, *GO, *QA, *KA, *VA, *GR, *GA; float *LFF, *LFB; const float* lb; };
__device__ __forceinline__ int t5_bucket(int rel) {
    const int ret = rel > 0 ? 16 : 0, n = rel < 0 ? -rel : rel;
    if (n < 8) return ret + n;
    int large = 8 + (int)(logf((float)n / 8.0f) / 4.852030263919617f * 8.0f);
    large = large < 15 ? large : 15;
    return ret + large;
}

#define GAS __attribute__((address_space(1)))
#define LAS __attribute__((address_space(3)))
typedef unsigned v4u __attribute__((ext_vector_type(4)));
typedef float f32x4 __attribute__((ext_vector_type(4)));
#define LDS_WAIT() asm volatile("s_waitcnt lgkmcnt(0)" ::: "memory")
#define VM_WAIT() asm volatile("s_waitcnt vmcnt(0)" ::: "memory")
typedef float f32x2_t __attribute__((ext_vector_type(2)));
typedef __bf16 bf16x2_t __attribute__((ext_vector_type(2)));
__device__ __forceinline__ unsigned pk2(float lo, float hi) { const f32x2_t v = {lo, hi}; const bf16x2_t b = __builtin_convertvector(v, bf16x2_t); return __builtin_bit_cast(unsigned, b); }
__device__ __forceinline__ float bflo(unsigned u) { return __uint_as_float(u << 16); }
__device__ __forceinline__ float bfhi(unsigned u) { return __uint_as_float(u & 0xffff0000u); }
__device__ __forceinline__ float fsig(float v) { return __builtin_amdgcn_rcpf(1.0f + __expf(-v)); }

#ifndef PG8_AUX
#define PG8_AUX 0
#endif
namespace pg8 {
#define PG8_LAS __attribute__((address_space(3)))
typedef short bf16x8 __attribute__((ext_vector_type(8)));
typedef unsigned u32x4 __attribute__((ext_vector_type(4)));
constexpr int BM = 256, BK = 64, HALF = 128, HTB = HALF * BK * 2, STAGE_BYTES = 8 * HTB, NXCD = 8, WGM = 8;
__host__ __device__ __forceinline__ int lds_byte(int r, int c) { const int st = (r >> 4) * 2 + (c >> 5), rr = r & 15, cc = c & 31, ob = rr * 64 + cc * 2; return st * 1024 + (ob ^ (((ob >> 9) & 1) << 5)); }
__host__ __device__ __forceinline__ void stage_rc(int b, int& R, int& C) { const int st = b / 1024, sb = b % 1024, swz = sb ^ (((sb >> 9) & 1) << 5); R = (st >> 1) * 16 + swz / 64; C = (st & 1) * 32 + (swz % 64) / 2; }
__host__ __device__ __forceinline__ int perm32(int rho) { const int n = rho >> 4, i = rho & 15; return 8 * (i >> 2) + 4 * n + (i & 3); }
typedef int v8i __attribute__((ext_vector_type(8)));
typedef int v4i __attribute__((ext_vector_type(4)));
template <bool F8> struct FragSel { struct A_t { bf16x8 v[4][2]; }; struct B_t { bf16x8 v[2][2]; }; };
template <> struct FragSel<true> { struct A_t { v8i v[4]; }; struct B_t { v8i v[2]; }; };
__device__ __forceinline__ v8i cat16(bf16x8 lo, bf16x8 hi) { const v4i a = __builtin_bit_cast(v4i, lo), b = __builtin_bit_cast(v4i, hi); return __builtin_shufflevector(a, b, 0, 1, 2, 3, 4, 5, 6, 7); }
struct Unit { int pm, pn, pb, e; };
struct Gemm { const bf16_t* A; const bf16_t* Bt; int K; const int* rowidx; };
struct StaticOrder {
    int nM, nN, nwg, G, c;
    __device__ void init(int M, int N, int G_, int c_) { nM = M / BM; nN = N / BM; nwg = nM * nN; G = G_; c = c_; }
    __device__ bool next(int i, Unit& u) const {
        const long L = (long)i * G + c; if (L >= nwg) return false;
        int wgid = (int)L; { const int q = nwg / NXCD, r = nwg % NXCD, xcd = wgid % NXCD, off = wgid / NXCD; wgid = (xcd < r ? xcd * (q + 1) : r * (q + 1) + (xcd - r) * q) + off; }
        const int nig = WGM * nN, gid = wgid / nig, fm = gid * WGM, gsz = (nM - fm) < WGM ? (nM - fm) : WGM;
        u.pm = fm + ((wgid % nig) % gsz); u.pn = (wgid % nig) / gsz; u.pb = u.pn; u.e = 0; return true;
    }
};
__device__ const signed char kProjPerm[54] = {38, 40, 42, 44, 46, 48, 50, 52, 16, 18, 0, 2, 8, 10, 12, 14, 4, 6, 20, 22, 24, 26, 28, 30, 32, 34, 36, 39, 41, 43, 45, 47, 49, 51, 53, 17, 19, 1, 3, 9, 11, 13, 15, 5, 7, 21, 23, 25, 27, 29, 31, 33, 35, 37};
struct ProjOrder : StaticOrder {
    __device__ bool next(int i, Unit& u) const { if (!StaticOrder::next(i, u)) return false; u.pn = kProjPerm[u.pn]; u.pb = u.pn; return true; }
};
struct ListOrder {
    const LAS int* tab; int n;
    __device__ bool next(int i, Unit& u) const { if (i >= n) return false; u.pm = tab[4 * i]; u.pn = tab[4 * i + 1]; u.pb = tab[4 * i + 2]; u.e = tab[4 * i + 3]; return true; }
};

template <class Epi, class Sched, bool ALIGN_EPI, bool SP2 = true, bool GATHER = false, bool F8 = false>
__device__ __forceinline__ void gemm_phase(PG8_LAS unsigned char* lds, const Gemm g, const Sched& S, const Epi& E) {
    const int tid = threadIdx.x, wid = __builtin_amdgcn_readfirstlane(tid >> 6), lane = tid & 63, wr = wid >> 2, wc = wid & 3, fr = lane & 15, fq = lane >> 4;
    const int K = g.K, rowb = F8 ? K : 2 * K, nt = rowb / 128;
    unsigned voffB[2];
#pragma unroll
    for (int i = 0; i < 2; ++i) { int R, C; stage_rc(tid * 16 + i * 8192, R, C); const int Rb = Epi::PERM ? ((R & ~31) + perm32(R & 31)) : R;
        voffB[i] = (unsigned)(Rb * rowb + C * 2); }
#define PG8_SET_AOFF(o, u) do { _Pragma("unroll") for (int _h = 0; _h < 2; ++_h) _Pragma("unroll") for (int _i = 0; _i < 2; ++_i) { int _R, _C; stage_rc((int)threadIdx.x * 16 + _i * 8192, _R, _C); int _row = (u).pm * BM + _h * HALF + _R; \
        if (GATHER) { const int _t = g.rowidx[((u).e & 31) * 8192 + (((u).e >> 12) & 63) * BM + _h * HALF + _R]; _row = _t < 0 ? 0 : _t; } (o)[_h][_i] = (unsigned)(_row * rowb + _C * 2); } } while (0)
#define PG8_STAGE_A(bufoff, o0, o1, kb) do { __builtin_amdgcn_global_load_lds((const unsigned*)((const char*)g.A + (o0) + (kb)), (PG8_LAS unsigned*)(lds + (bufoff) + ldsw), 16, 0, PG8_AUX); \
        __builtin_amdgcn_global_load_lds((const unsigned*)((const char*)g.A + (o1) + (kb)), (PG8_LAS unsigned*)(lds + (bufoff) + ldsw + 8192), 16, 0, PG8_AUX); } while (0)
    const size_t kstep = (size_t)(BK * 2);
    const size_t hstep = (size_t)HALF * rowb;
    const size_t tstep = 2 * hstep;
    const unsigned ldsw = (unsigned)wid * 1024u;
    const int aoff = lds_byte(wr * 64 + fr, fq * 8), boff = lds_byte(wc * 32 + fr, fq * 8);
#define PG8_SA(b, h) (((b) * 2 + (h)) * HTB)
#define PG8_SB(b, h) ((4 + (b) * 2 + (h)) * HTB)
#define PG8_STAGE(bufoff, gbase, voff) do { _Pragma("unroll") for (int _i = 0; _i < 2; ++_i) \
        __builtin_amdgcn_global_load_lds((const unsigned*)((const char*)(gbase) + (voff)[_i]), (PG8_LAS unsigned*)(lds + (bufoff) + ldsw + _i * 8192), 16, 0, PG8_AUX); } while (0)
#define PG8_LDA(dst, b, h) do { _Pragma("unroll") for (int m = 0; m < 4; ++m) { \
        if constexpr (F8) dst.v[m] = cat16(*(const PG8_LAS bf16x8*)(lds + PG8_SA(b, h) + aoff + m * 2048), *(const PG8_LAS bf16x8*)(lds + PG8_SA(b, h) + aoff + m * 2048 + 1024)); \
        else { _Pragma("unroll") for (int k = 0; k < 2; ++k) dst.v[m][k] = *(const PG8_LAS bf16x8*)(lds + PG8_SA(b, h) + aoff + m * 2048 + k * 1024); } } } while (0)
#define PG8_LDB(dst, b, h) do { _Pragma("unroll") for (int n = 0; n < 2; ++n) { \
        if constexpr (F8) dst.v[n] = cat16(*(const PG8_LAS bf16x8*)(lds + PG8_SB(b, h) + boff + n * 2048), *(const PG8_LAS bf16x8*)(lds + PG8_SB(b, h) + boff + n * 2048 + 1024)); \
        else { _Pragma("unroll") for (int k = 0; k < 2; ++k) dst.v[n][k] = *(const PG8_LAS bf16x8*)(lds + PG8_SB(b, h) + boff + n * 2048 + k * 1024); } } } while (0)
#define PG8_MMA(ai, bj, At, Bt) do { __builtin_amdgcn_s_setprio(1); _Pragma("unroll") for (int m = 0; m < 4; ++m) _Pragma("unroll") for (int n = 0; n < 2; ++n) { \
        if constexpr (F8) asm volatile("v_mfma_scale_f32_16x16x128_f8f6f4 %0, %1, %2, %0, %3, %3 op_sel_hi:[0,0,0]" : "+v"(acc[ai][bj][m][n]) : "v"(Bt.v[n]), "v"(At.v[m]), "v"(f8scale)); \
        else { _Pragma("unroll") for (int k = 0; k < 2; ++k) acc[ai][bj][m][n] = __builtin_amdgcn_mfma_f32_16x16x32_bf16(Bt.v[n][k], At.v[m][k], acc[ai][bj][m][n], 0, 0, 0); } } \
        __builtin_amdgcn_s_setprio(0); } while (0)
#define PG8_WAIT_V(n) asm volatile("s_waitcnt vmcnt(" #n ")" ::: "memory")
#define PG8_WAIT_L(n) asm volatile("s_waitcnt lgkmcnt(" #n ")" ::: "memory")
#define PG8_BAR __builtin_amdgcn_s_barrier()
#define PG8_SCHED __builtin_amdgcn_sched_barrier(0)
    Unit cur, nxt; int ui = 0;
    if (!S.next(0, cur)) return;
    f32x4 acc[2][2][4][2];
#pragma unroll
    for (int a = 0; a < 2; ++a)
#pragma unroll
        for (int b = 0; b < 2; ++b)
#pragma unroll
            for (int m = 0; m < 4; ++m)
#pragma unroll
                for (int n = 0; n < 2; ++n) acc[a][b][m][n] = (f32x4){0.f, 0.f, 0.f, 0.f};
    int f8scale = 0x7f7f7f7f; asm volatile("" : "+v"(f8scale));
    typedef typename FragSel<F8>::A_t FragA; typedef typename FragSel<F8>::B_t FragB;
    FragA At; FragB B0, B1;
    const char* cB = (const char*)g.Bt + (size_t)cur.pb * tstep;
    unsigned AGO_[2][2], NAGO_[2][2]; PG8_SET_AOFF(AGO_, cur);
    if constexpr (SP2) {
    PG8_STAGE(PG8_SB(0, 0), cB, voffB); PG8_STAGE(PG8_SB(0, 1), cB + hstep, voffB); PG8_STAGE_A(PG8_SA(0, 0), AGO_[0][0], AGO_[0][1], 0); PG8_STAGE_A(PG8_SA(0, 1), AGO_[1][0], AGO_[1][1], 0);
    if (wr == 1) PG8_BAR;
    PG8_WAIT_V(2); PG8_BAR;
    PG8_STAGE(PG8_SB(1, 0), cB + kstep, voffB); PG8_STAGE_A(PG8_SA(1, 0), AGO_[0][0], AGO_[0][1], kstep); PG8_STAGE(PG8_SB(1, 1), cB + hstep + kstep, voffB);
    PG8_WAIT_V(6); PG8_BAR;
    }
    for (;;) {
        const bool has_next = S.next(ui + 1, nxt);
        const char* nB = has_next ? (const char*)g.Bt + (size_t)nxt.pb * tstep : cB;
        if (has_next) { PG8_SET_AOFF(NAGO_, nxt); } else {
#pragma unroll
            for (int _h = 0; _h < 2; ++_h)
#pragma unroll
                for (int _i = 0; _i < 2; ++_i) NAGO_[_h][_i] = AGO_[_h][_i]; }
        for (int t = 0; t < nt; t += 2) {
            const bool last = (t == nt - 2);
            const unsigned k1 = (unsigned)(t + 1) * (unsigned)kstep, k2 = last ? 0u : (unsigned)(t + 2) * (unsigned)kstep, k3 = k2 + (unsigned)kstep;
            const unsigned p00 = last ? NAGO_[0][0] : AGO_[0][0], p01 = last ? NAGO_[0][1] : AGO_[0][1], p10 = last ? NAGO_[1][0] : AGO_[1][0], p11 = last ? NAGO_[1][1] : AGO_[1][1];
            const char* b2 = last ? nB : cB + (size_t)(t + 2) * kstep; const char* b3 = b2 + kstep;
            PG8_LDB(B0, 0, 0); PG8_LDB(B1, 0, 1); PG8_SCHED; PG8_LDA(At, 0, 0); PG8_STAGE_A(PG8_SA(1, 1), AGO_[1][0], AGO_[1][1], k1);
            PG8_WAIT_V(8); PG8_WAIT_L(0); PG8_BAR; PG8_MMA(0, 0, At, B0); PG8_MMA(0, 1, At, B1); PG8_BAR; PG8_SCHED;
            PG8_LDA(At, 0, 1); PG8_STAGE(PG8_SB(0, 0), b2, voffB); PG8_STAGE(PG8_SB(0, 1), b2 + hstep, voffB); PG8_STAGE_A(PG8_SA(0, 0), p00, p01, k2);
            PG8_WAIT_V(8); PG8_WAIT_L(0); PG8_BAR; if (!F8 || !(cur.e & 256)) { PG8_MMA(1, 0, At, B0); PG8_MMA(1, 1, At, B1); } PG8_BAR; PG8_SCHED;
            PG8_LDB(B0, 1, 0); PG8_LDB(B1, 1, 1); PG8_SCHED; PG8_LDA(At, 1, 0); PG8_STAGE_A(PG8_SA(0, 1), p10, p11, k2);
            PG8_WAIT_V(8); PG8_WAIT_L(0); PG8_BAR; PG8_MMA(0, 0, At, B0); PG8_MMA(0, 1, At, B1); PG8_BAR; PG8_SCHED;
            PG8_LDA(At, 1, 1); PG8_STAGE(PG8_SB(1, 0), b3, voffB); PG8_STAGE(PG8_SB(1, 1), b3 + hstep, voffB); PG8_STAGE_A(PG8_SA(1, 0), p00, p01, k3);
            PG8_WAIT_V(8); PG8_WAIT_L(0); PG8_BAR; if (!F8 || !(cur.e & 256)) { PG8_MMA(1, 0, At, B0); PG8_MMA(1, 1, At, B1); } PG8_BAR; PG8_SCHED;
        }
        if constexpr (ALIGN_EPI) { if (wr == 0) PG8_BAR; }
        E(acc, cur, wr, wc, fr, fq);
        if (!has_next) break;
#pragma unroll
        for (int a = 0; a < 2; ++a)
#pragma unroll
            for (int b = 0; b < 2; ++b)
#pragma unroll
                for (int m = 0; m < 4; ++m)
#pragma unroll
                    for (int n = 0; n < 2; ++n) acc[a][b][m][n] = (f32x4){0.f, 0.f, 0.f, 0.f};
        cur = nxt; cB = nB; ++ui;
#pragma unroll
        for (int _h = 0; _h < 2; ++_h)
#pragma unroll
            for (int _i = 0; _i < 2; ++_i) AGO_[_h][_i] = NAGO_[_h][_i];
        if constexpr (ALIGN_EPI) { if (wr == 1) PG8_BAR; }
    }
    PG8_WAIT_V(0);
    if constexpr (!ALIGN_EPI) { if (wr == 0) PG8_BAR; }
    PG8_BAR;
#undef PG8_SA
#undef PG8_SB
#undef PG8_STAGE
#undef PG8_STAGE_A
#undef PG8_SET_AOFF
#undef PG8_LDA
#undef PG8_LDB
#undef PG8_MMA
#undef PG8_WAIT_V
#undef PG8_WAIT_L
#undef PG8_BAR
#undef PG8_SCHED
}
}
typedef pg8::bf16x8 bfx8;
#define MFMA16(a, b, c) __builtin_amdgcn_mfma_f32_16x16x32_bf16(a, b, c, 0, 0, 0)

typedef f32x4 acc_t[2][2][4][2];
__device__ __forceinline__ v4u pack8(const float (&x)[8]) { v4u w; w.x = pk2(x[0], x[1]); w.y = pk2(x[2], x[3]); w.z = pk2(x[4], x[5]); w.w = pk2(x[6], x[7]); return w; }
typedef unsigned u32x2 __attribute__((ext_vector_type(2)));
__device__ __forceinline__ u32x2 pack8_fp8(const float (&x)[8]) {
    unsigned lo = 0, hi = 0;
    lo = __builtin_amdgcn_cvt_pk_fp8_f32(x[0], x[1], lo, false); lo = __builtin_amdgcn_cvt_pk_fp8_f32(x[2], x[3], lo, true);
    hi = __builtin_amdgcn_cvt_pk_fp8_f32(x[4], x[5], hi, false); hi = __builtin_amdgcn_cvt_pk_fp8_f32(x[6], x[7], hi, true);
    return (u32x2){lo, hi};
}
__device__ __forceinline__ void st_bf16x8(bf16_t* p, const float (&x)[8]) { v4u w; w.x = pk2(x[0], x[1]); w.y = pk2(x[2], x[3]); w.z = pk2(x[4], x[5]); w.w = pk2(x[6], x[7]); *(v4u*)p = w; }
__device__ __forceinline__ void st_f32x8_nt(float* p, const float (&x)[8]) { __builtin_nontemporal_store((f32x4){x[0], x[1], x[2], x[3]}, (f32x4*)p); __builtin_nontemporal_store((f32x4){x[4], x[5], x[6], x[7]}, (f32x4*)(p + 4)); }
__device__ __forceinline__ void st_f32x8(float* p, const float (&x)[8]) { *(f32x4*)p = (f32x4){x[0], x[1], x[2], x[3]}; *(f32x4*)(p + 4) = (f32x4){x[4], x[5], x[6], x[7]}; }
#define ACC8(x, acc, ai, bj, m) float x[8]; { const f32x4 _a = acc[ai][bj][m][0], _b = acc[ai][bj][m][1]; x[0] = _a[0]; x[1] = _a[1]; x[2] = _a[2]; x[3] = _a[3]; x[4] = _b[0]; x[5] = _b[1]; x[6] = _b[2]; x[7] = _b[3]; }

struct EpiProjT {
    static constexpr bool PERM = true;
    ProjOut P;
    template <int KIND> __device__ __forceinline__ void tile(const acc_t& acc, void* dst, int ld, int cb, const float* lbp, int row0, int wc, int fq) const {
        const int c0 = cb + wc * 32 + 8 * fq;
        float lbv[2][8];
        if (KIND == 2) {
#pragma unroll
            for (int bj = 0; bj < 2; ++bj) { const f32x4 a = *(const f32x4*)(lbp + c0 + 128 * bj), b = *(const f32x4*)(lbp + c0 + 128 * bj + 4);
                lbv[bj][0] = a[0]; lbv[bj][1] = a[1]; lbv[bj][2] = a[2]; lbv[bj][3] = a[3]; lbv[bj][4] = b[0]; lbv[bj][5] = b[1]; lbv[bj][6] = b[2]; lbv[bj][7] = b[3]; }
        }
#pragma unroll
        for (int ai = 0; ai < 2; ++ai)
#pragma unroll
            for (int m = 0; m < 4; ++m) {
                const size_t rowoff = (size_t)(row0 + ai * 128 + m * 16) * ld;
#pragma unroll
                for (int bj = 0; bj < 2; ++bj) {
                    ACC8(x, acc, ai, bj, m);
                    const int col = c0 + 128 * bj;
                    if (KIND == 2) {
#pragma unroll
                        for (int j = 0; j < 8; ++j) { const float l = lbv[bj][j]; x[j] = __logf(l + (1.0f - l) * fsig(x[j])); }
                        { typedef _Float16 h2_t __attribute__((ext_vector_type(2))); v4u w;
                          w.x = __builtin_bit_cast(unsigned, (h2_t){(_Float16)x[0], (_Float16)x[1]}); w.y = __builtin_bit_cast(unsigned, (h2_t){(_Float16)x[2], (_Float16)x[3]});
                          w.z = __builtin_bit_cast(unsigned, (h2_t){(_Float16)x[4], (_Float16)x[5]}); w.w = __builtin_bit_cast(unsigned, (h2_t){(_Float16)x[6], (_Float16)x[7]});
                          *(v4u*)((unsigned short*)dst + rowoff + col) = w; }
                    } else {
#pragma unroll
                        for (int j = 0; j < 8; ++j) { if (KIND == 0) x[j] = x[j] * fsig(x[j]); if (KIND == 3) x[j] = fsig(x[j]); if (KIND == 4) x[j] *= 0.08838834764831845f; }
                        st_bf16x8((bf16_t*)dst + rowoff + col, x);
                    }
                }
            }
    }
    __device__ __forceinline__ void operator()(const acc_t& acc, const pg8::Unit& u, int wr, int wc, int fr, int fq) const {
        const int row0 = u.pm * 256 + wr * 64 + fr, colt = u.pn * 256;
        if (colt < 1024) tile<0>(acc, P.QR, 1024, colt, nullptr, row0, wc, fq);
        else if (colt < 2048) tile<1>(acc, P.VR, 1024, colt - 1024, nullptr, row0, wc, fq);
        else if (colt < 3072) tile<2>(acc, P.LFF, 1024, colt - 2048, P.lb, row0, wc, fq);
        else if (colt < 4096) tile<2>(acc, P.LFB, 1024, colt - 3072, P.lb + 1024, row0, wc, fq);
        else if (colt < 5120) tile<3>(acc, P.GO, 1024, colt - 4096, nullptr, row0, wc, fq);
        else if (colt < 6656) tile<4>(acc, P.QA, 1536, colt - 5120, nullptr, row0, wc, fq);
        else if (colt < 8192) tile<1>(acc, P.KA, 1536, colt - 6656, nullptr, row0, wc, fq);
        else if (colt < 9728) tile<1>(acc, P.VA, 1536, colt - 8192, nullptr, row0, wc, fq);
        else if (colt < 11776) tile<3>(acc, P.GR, 2048, colt - 9728, nullptr, row0, wc, fq);
        else tile<3>(acc, P.GA, 2048, colt - 11776, nullptr, row0, wc, fq);
    }
};
struct EpiF32T {
    static constexpr bool PERM = true;
    float* C; int ldc;
    __device__ __forceinline__ void operator()(const acc_t& acc, const pg8::Unit& u, int wr, int wc, int fr, int fq) const {
        const int row0 = u.pm * 256 + wr * 64 + fr, c0 = u.pn * 256 + wc * 32 + 8 * fq;
#pragma unroll
        for (int ai = 0; ai < 2; ++ai)
#pragma unroll
            for (int m = 0; m < 4; ++m)
#pragma unroll
                for (int bj = 0; bj < 2; ++bj) { ACC8(x, acc, ai, bj, m); st_f32x8(C + (size_t)(row0 + ai * 128 + m * 16) * ldc + c0 + 128 * bj, x); }
    }
};
struct EpiBf16T {
    static constexpr bool PERM = true;
    bf16_t* C; int ldc;
    __device__ __forceinline__ void operator()(const acc_t& acc, const pg8::Unit& u, int wr, int wc, int fr, int fq) const {
        const int row0 = u.pm * 256 + wr * 64 + fr, c0 = u.pn * 256 + wc * 32 + 8 * fq;
#pragma unroll
        for (int ai = 0; ai < 2; ++ai)
#pragma unroll
            for (int m = 0; m < 4; ++m)
#pragma unroll
                for (int bj = 0; bj < 2; ++bj) { ACC8(x, acc, ai, bj, m); st_bf16x8(C + (size_t)(row0 + ai * 128 + m * 16) * ldc + c0 + 128 * bj, x); }
    }
};
struct EpiMergeT {
    static constexpr bool PERM = true;
    const bf16_t* YR; const bf16_t* GR; const bf16_t* GA; bf16_t* MG;
    __device__ __forceinline__ void operator()(const acc_t& acc, const pg8::Unit& u, int wr, int wc, int fr, int fq) const {
        const int row0 = u.pm * 256 + wr * 64 + fr, c0 = u.pn * 256 + wc * 32 + 8 * fq;
#pragma unroll
        for (int ai = 0; ai < 2; ++ai)
#pragma unroll
            for (int m = 0; m < 4; ++m)
#pragma unroll
                for (int bj = 0; bj < 2; ++bj) {
                    ACC8(x, acc, ai, bj, m);
                    const size_t o = (size_t)(row0 + ai * 128 + m * 16) * D + c0 + 128 * bj;
                    const v4u gr = *(const v4u*)(GR + o), ga = *(const v4u*)(GA + o), yr = *(const v4u*)(YR + o); const f32x4 y0 = {bflo(yr.x), bfhi(yr.x), bflo(yr.y), bfhi(yr.y)}, y1 = {bflo(yr.z), bfhi(yr.z), bflo(yr.w), bfhi(yr.w)};
                    x[0] = bflo(gr.x) * y0[0] + bflo(ga.x) * x[0]; x[1] = bfhi(gr.x) * y0[1] + bfhi(ga.x) * x[1];
                    x[2] = bflo(gr.y) * y0[2] + bflo(ga.y) * x[2]; x[3] = bfhi(gr.y) * y0[3] + bfhi(ga.y) * x[3];
                    x[4] = bflo(gr.z) * y1[0] + bflo(ga.z) * x[4]; x[5] = bfhi(gr.z) * y1[1] + bfhi(ga.z) * x[5];
                    x[6] = bflo(gr.w) * y1[2] + bflo(ga.w) * x[6]; x[7] = bfhi(gr.w) * y1[3] + bfhi(ga.w) * x[7];
                    st_bf16x8(MG + o, x);
                }
    }
};
struct EpiGateUpT {
    static constexpr bool PERM = true;
    const float* bgu; unsigned char* ACT;
    __device__ __forceinline__ void operator()(const acc_t& acc, const pg8::Unit& u, int wr, int wc, int fr, int fq) const {
        const int row0 = u.pm * 256 + wr * 64 + fr, c0 = u.pn * 128 + wc * 32 + 8 * fq;
        const float* bg = bgu + (size_t)(u.e & 255) * 2 * DFF + c0;
        float bgv[8], buv[8];
        { const f32x4 a = *(const f32x4*)bg, b = *(const f32x4*)(bg + 4), c = *(const f32x4*)(bg + DFF), d = *(const f32x4*)(bg + DFF + 4);
#pragma unroll
          for (int j = 0; j < 4; ++j) { bgv[j] = a[j]; bgv[4 + j] = b[j]; buv[j] = c[j]; buv[4 + j] = d[j]; } }
#pragma unroll
        for (int ai = 0; ai < 2; ++ai)
#pragma unroll
            for (int m = 0; m < 4; ++m) {
                ACC8(g, acc, ai, 0, m); ACC8(up, acc, ai, 1, m);
#pragma unroll
                for (int j = 0; j < 8; ++j) { const float gt = fminf(g[j] * 0.015625f + bgv[j], 7.0f), uu = fminf(fmaxf(up[j] * 0.015625f + buv[j], -7.0f), 7.0f); g[j] = gt * fsig(1.702f * gt) * (uu + 1.0f); }
                *(u32x2*)(ACT + (size_t)(row0 + ai * 128 + m * 16) * DFF + c0) = pack8_fp8(g);
            }
    }
};
struct EpiDownT {
    static constexpr bool PERM = true;
    const float* bd; const float* SW; bf16_t* YB;
    __device__ __forceinline__ void operator()(const acc_t& acc, const pg8::Unit& u, int wr, int wc, int fr, int fq) const {
        const int row0 = u.pm * 256 + wr * 64 + fr, c0 = u.pn * 256 + wc * 32 + 8 * fq;
        float bv[2][8];
#pragma unroll
        for (int bj = 0; bj < 2; ++bj) { const float* bp = bd + (size_t)(u.e & 255) * D + c0 + 128 * bj; const f32x4 a = *(const f32x4*)bp, b = *(const f32x4*)(bp + 4);
#pragma unroll
            for (int j = 0; j < 4; ++j) { bv[bj][j] = a[j]; bv[bj][4 + j] = b[j]; } }
#pragma unroll
        for (int ai = 0; ai < 2; ++ai)
#pragma unroll
            for (int m = 0; m < 4; ++m) {
                const int row = row0 + ai * 128 + m * 16; const float w = SW[(u.e & 31) * 8192 + ((u.e >> 12) & 63) * 256 + (row - u.pm * 256)];
#pragma unroll
                for (int bj = 0; bj < 2; ++bj) { ACC8(x, acc, ai, bj, m);
#pragma unroll
                    for (int j = 0; j < 8; ++j) x[j] = (x[j] * 0.015625f + bv[bj][j]) * w;
                    st_bf16x8(YB + (size_t)row * D + c0 + 128 * bj, x); }
            }
    }
};

#define XB_TMO      128
#define XB_XCNT(j)  (256  + 64 * (j))
#define XB_XSUB(j)  (1280 + 64 * (j))
#define XB_XGEN(j)  (2304 + 64 * (j))
#define XB_TOP      3328
#define XB_TOPGEN   3392
#define XCD_BAR_WORDS 3456
#define XB_SPIN_CAP (1u << 18)
__device__ __forceinline__ unsigned xb_ld(unsigned* p)              { return __hip_atomic_load(p, __ATOMIC_RELAXED, __HIP_MEMORY_SCOPE_AGENT); }
__device__ __forceinline__ unsigned xb_add(unsigned* p, unsigned v) { return __hip_atomic_fetch_add(p, v, __ATOMIC_RELAXED, __HIP_MEMORY_SCOPE_AGENT); }
__device__ __forceinline__ unsigned xb_xcc_id() { return (unsigned)__builtin_amdgcn_s_getreg((3 << 11) | 20) & 0xFu; }
#define XB_SPIN(cond, bar) do { unsigned _sp = 0; while (cond) { __builtin_amdgcn_s_sleep(1); \
    if ((++_sp & 255u) == 0u) { if (xb_ld(&(bar)[XB_TMO])) break; if (_sp > XB_SPIN_CAP) { atomicAdd(&(bar)[XB_TMO], 1u); break; } } } } while (0)
struct XcdBarrier { unsigned* bar; unsigned x; volatile LAS unsigned* st; unsigned total; };
__device__ __forceinline__ XcdBarrier xcd_barrier_post(unsigned* bar, volatile LAS unsigned* st, unsigned total) {
    XcdBarrier b; b.bar = bar; b.x = xb_xcc_id(); b.st = st; b.total = total;
    if (threadIdx.x == 0) (void)xb_add(&bar[XB_XCNT(b.x)], 1u);
    return b;
}
__device__ __forceinline__ void xcd_barrier_complete(unsigned* bar, unsigned x, unsigned G, unsigned& nloc, unsigned& nx) {
    unsigned sum, cnt, mine, sp = 0u;
    for (;;) {
        sum = 0u; cnt = 0u; mine = 0u;
#pragma unroll
        for (unsigned j = 0; j < 16; ++j) { const unsigned c = xb_ld(&bar[XB_XCNT(j)]); sum += c; cnt += (c > 0u) ? 1u : 0u; mine = (j == x) ? c : mine; }
        if (sum == G) break;
        __builtin_amdgcn_s_sleep(1);
        if ((++sp & 255u) == 0u) { if (xb_ld(&bar[XB_TMO])) break; if (sp > XB_SPIN_CAP) { atomicAdd(&bar[XB_TMO], 1u); break; } }
    }
    nloc = mine > 0u ? mine : 1u; nx = cnt > 0u ? cnt : 1u;
}
__device__ __forceinline__ void xcd_barrier(const XcdBarrier& b) {
    asm volatile("s_waitcnt vmcnt(0)" ::: "memory");
    __syncthreads();
    if (threadIdx.x == 0) {
        unsigned* bar = b.bar;
        __builtin_amdgcn_s_waitcnt(0);
        unsigned nloc = b.st[0], nx = b.st[1];
        if (nloc == 0u) { xcd_barrier_complete(bar, b.x, b.total, nloc, nx); b.st[0] = nloc; b.st[1] = nx; }
        const unsigned old = xb_add(&bar[XB_XSUB(b.x)], 1u);
        const unsigned gen = old / nloc;
        if (old + 1u == (gen + 1u) * nloc) {
            __builtin_amdgcn_fence(__ATOMIC_RELEASE, "agent");
            asm volatile("s_waitcnt vmcnt(0)" ::: "memory");
            const unsigned og = xb_add(&bar[XB_TOP], 1u);
            const unsigned tg = og / nx;
            if (og + 1u == (tg + 1u) * nx) xb_add(&bar[XB_TOPGEN], 1u);
            else XB_SPIN(xb_ld(&bar[XB_TOPGEN]) == tg, bar);
            __builtin_amdgcn_fence(__ATOMIC_ACQUIRE, "agent");
            xb_add(&bar[XB_XGEN(b.x)], 1u);
            asm volatile("s_waitcnt vmcnt(0)" ::: "memory");
        } else {
            XB_SPIN(xb_ld(&bar[XB_XGEN(b.x)]) == gen, bar);
            __builtin_amdgcn_fence(__ATOMIC_ACQUIRE, "agent");
            asm volatile("s_waitcnt vmcnt(0)" ::: "memory");
        }
    }
    __syncthreads();
}

constexpr int NWAVES = 8;
constexpr int RING_BYTES = 131072, LDSCTL_OFF = RING_BYTES, LDS_BYTES = 163840;
constexpr int MISC_OFF = LDSCTL_OFF;
constexpr int RT_OFF = LDSCTL_OFF + 128;
constexpr int UL_OFF = LDSCTL_OFF + 512;
constexpr int CW_BAR = 8192;
constexpr int NPH = 13; constexpr int CW_DIAG_T = 20480 + 32;
struct Args { const float* in[21]; float* out; unsigned char* ws; int ph_lo, ph_hi, li, pad; };

struct Ctx { LAS unsigned char* lds; int tid, lane, wave, vcu, G; };

constexpr int M_IN = 16 * 108, M_BR = 8 * 16, M_BA = 4 * 16, M_O = 16 * 16, M_GU = 32 * 16 * 32, M_DN = 32 * 16 * 16, M_EXP = M_GU + M_DN, NMAC = M_IN + M_BR + M_BA + M_O + M_GU + M_DN;
constexpr int CW_Q0 = 6144 + 64, CW_Q1 = 6144 + 128, CW_Q2 = 6144 + 192, CW_Q3 = 6144 + 256;
constexpr int CONV_PER_32 = 5;
template <bool F8Q = false>
__device__ __forceinline__ void convert_stream(const Args& a, const Ctx& F, unsigned* Q, int lo, int hi) {
    unsigned char* ws = a.ws;
    struct Mac { const float* W; int ldw; unsigned char* dst; int ldd; int f8; int gu; int n0; };
    auto decode = [&](int r) -> Mac {
        Mac t; t.gu = 0; t.f8 = 0; t.n0 = 0;
        if (r < M_GU) { const int e = r >> 9, rr = r & 511, kb = rr >> 5, nb = rr & 31;
            t.W = a.in[15] + (size_t)e * D * 4096 + (size_t)(128 * kb) * 4096 + 128 * nb; t.ldw = 4096; t.dst = ws + WS_WGU_T + (size_t)e * 4096 * 2048 + 128 * kb; t.ldd = 2048; t.f8 = 1; t.gu = 1; t.n0 = 128 * nb; }
        else if ((r -= M_GU) < M_DN) { const int e = r >> 8, rr = r & 255, kb = rr >> 4, nb = rr & 15;
            t.W = a.in[17] + (size_t)e * DFF * D + (size_t)(128 * kb) * D + 128 * nb; t.ldw = D; t.dst = ws + WS_WDN_T + ((size_t)e * 2048 + 128 * nb) * 2048 + 128 * kb; t.ldd = 2048; t.f8 = 1; }
        else if ((r -= M_DN) < M_O) { const int kb = r >> 4, nb = r & 15; t.W = a.in[12] + (size_t)(128 * kb) * D + 128 * nb; t.ldw = D; t.dst = ws + WS_WO_T + ((size_t)(128 * nb) * 2048 + 128 * kb) * 2; t.ldd = 2048 * 2; }
        else if ((r -= M_O) < M_BR) { const int kb = r >> 4, nb = r & 15; t.W = a.in[10] + (size_t)(128 * kb) * D + 128 * nb; t.ldw = D; t.dst = ws + WS_WBR_T + ((size_t)(128 * nb) * 1024 + 128 * kb) * 2; t.ldd = 1024 * 2; }
        else if ((r -= M_BR) < M_BA) { const int kb = r >> 4, nb = r & 15; t.W = a.in[11] + (size_t)(128 * kb) * D + 128 * nb; t.ldw = D; t.dst = ws + WS_WBA_T + ((size_t)(128 * nb) * 512 + 128 * kb) * 2; t.ldd = 512 * 2; }
        else { r -= M_BA; const int kb = r / 108, nb = r % 108; t.W = a.in[8] + (size_t)(128 * kb) * DIN + 128 * nb; t.ldw = DIN; t.dst = ws + WS_WIN_T + ((size_t)(128 * nb) * 2048 + 128 * kb) * 2; t.ldd = 2048 * 2; }
        return t;
    };
    const int lane = F.lane, w = F.wave;
#define P0_LOAD(rg, m) do { _Pragma("unroll") for (int i = 0; i < 8; ++i) rg[i] = __builtin_nontemporal_load((const f32x4*)((m).W + (size_t)(16 * w + 2 * i + (lane >> 5)) * (m).ldw + 4 * (lane & 31))); } while (0)
#define P0_STEP(rg, me, have_nxt, nxt_idx, buf) do { \
        LAS float* tile = (LAS float*)(F.lds + (buf) * 65536); \
        _Pragma("unroll") for (int i = 0; i < 8; ++i) { const int k = 16 * w + 2 * i + (lane >> 5); *(LAS f32x4*)(tile + k * 128 + ((4 * (lane & 31)) ^ (4 * ((k >> 3) & 7)))) = rg[i]; } \
        const Mac mcur = me; \
        if (have_nxt) { me = decode(nxt_idx); P0_LOAD(rg, me); } \
        __syncthreads(); \
        const int c = lane & 15; \
        _Pragma("unroll") for (int j = 0; j < 4; ++j) { const int nl = 16 * w + (lane >> 4) + 4 * j; float x[8]; \
            _Pragma("unroll") for (int i = 0; i < 8; ++i) x[i] = tile[(8 * c + i) * 128 + (nl ^ (4 * (c & 7)))]; \
            size_t row = (size_t)nl; \
            if (mcur.gu) { const int n = mcur.n0 + nl, half = n >> 11, nn = n & 2047; row = (size_t)(256 * (nn >> 7) + 128 * half + (nn & 127)); } \
            if (mcur.f8) { _Pragma("unroll") for (int i = 0; i < 8; ++i) x[i] *= 64.0f; __builtin_nontemporal_store(pack8_fp8(x), (GAS u32x2*)(mcur.dst + row * mcur.ldd + 8 * c)); } \
            else *(GAS v4u*)(mcur.dst + row * mcur.ldd + 16 * c) = pack8(x); } } while (0)
#define P8_LOAD(rg, m) do { _Pragma("unroll") for (int i = 0; i < 8; ++i) rg[i] = __builtin_nontemporal_load((const f32x4*)((m).W + (size_t)(16 * w + 8 * (lane >> 5) + i) * (m).ldw + 4 * (lane & 31))); } while (0)
#define P8_STEP(rg, me, have_nxt, nxt_idx, buf) do { \
        LAS unsigned char* tT = F.lds + (buf) * 16384; \
        { const int c4 = lane & 31, g8 = 2 * w + (lane >> 5); \
          _Pragma("unroll") for (int j = 0; j < 4; ++j) { float x8[8]; \
              _Pragma("unroll") for (int i = 0; i < 8; ++i) x8[i] = rg[i][j] * 64.0f; \
              *(LAS u32x2*)(tT + (4 * c4 + j) * 128 + ((g8 ^ (c4 & 15)) << 3)) = pack8_fp8(x8); } } \
        const Mac mcur = me; \
        if (have_nxt) { me = decode(nxt_idx); P8_LOAD(rg, me); } \
        __syncthreads(); \
        const int rowbase = mcur.gu ? 256 * ((mcur.n0 & 2047) >> 7) + 128 * (mcur.n0 >> 11) : 0; \
        _Pragma("unroll") for (int t_ = 0; t_ < 2; ++t_) { const int idx = F.tid + 512 * t_, n = idx >> 3, m = idx & 7, sw = (n >> 2) & 15; \
            v4u q_ = *(const LAS v4u*)(tT + n * 128 + ((m ^ (sw >> 1)) << 4)); if (sw & 1) q_ = (v4u){q_.z, q_.w, q_.x, q_.y}; \
            __builtin_nontemporal_store(q_, (GAS v4u*)(mcur.dst + (size_t)(rowbase + n) * mcur.ldd + 16 * m)); } } while (0)
    volatile LAS int* qs = (volatile LAS int*)(F.lds + MISC_OFF) + 16;
    const int NP = (hi - lo) >> 1;
    __syncthreads();
    if (F.tid == 0) { qs[0] = (int)xb_add(Q, 1u); qs[1] = (int)xb_add(Q, 1u); }
    __syncthreads();
    int pc = qs[0], pn = qs[1], it = 0;
    f32x4 rgA[8], rgB[8];
    Mac mA = decode(lo + 2 * (pc < NP ? pc : 0)), mB = decode(lo + 2 * (pc < NP ? pc : 0) + 1);
    if constexpr (F8Q) {
        if (pc < NP) { P8_LOAD(rgA, mA); P8_LOAD(rgB, mB); }
        while (pc < NP) {
            int nx = 0; if (F.tid == 0) nx = (int)xb_add(Q, 1u);
            P8_STEP(rgA, mA, pn < NP, lo + 2 * pn, 0);
            if (F.tid == 0) qs[it & 1] = nx;
            P8_STEP(rgB, mB, pn < NP, lo + 2 * pn + 1, 1);
            pc = pn; pn = qs[it & 1]; ++it;
        }
    } else {
        if (pc < NP) { P0_LOAD(rgA, mA); P0_LOAD(rgB, mB); }
        while (pc < NP) {
            int nx = 0; if (F.tid == 0) nx = (int)xb_add(Q, 1u);
            P0_STEP(rgA, mA, pn < NP, lo + 2 * pn, 0);
            if (F.tid == 0) qs[it & 1] = nx;
            P0_STEP(rgB, mB, pn < NP, lo + 2 * pn + 1, 1);
            pc = pn; pn = qs[it & 1]; ++it;
        }
    }
#undef P0_LOAD
#undef P0_STEP
#undef P8_LOAD
#undef P8_STEP
    __syncthreads();
}

__device__ __forceinline__ void p1_norm_mod(const Args& a, const Ctx& F);
constexpr int CW_ADA01 = 6144 + 448;
__device__ __forceinline__ void p0_prologue(const Args& a, const Ctx& F) {
    unsigned char* ws = a.ws;
    const int gtid = F.vcu * 512 + F.tid, NT_ = F.G * 512;
    { int* STOK = (int*)(ws + WS_STOK); for (int r = gtid; r < 32 * 8192; r += NT_) STOK[r] = -1; }
    { const float* tab = a.in[19]; float* lb = (float*)(ws + WS_LB);
      for (int i = gtid; i < 2048; i += NT_) { const int dir = i >> 10, c = i & 1023; lb[i] = 1.0f / (1.0f + expf(tab[dir * 2048 + 1024 + c] - tab[dir * 2048 + c])); } }
    { const float* wr = a.in[13]; bf16_t* WRT = (bf16_t*)(ws + WS_WRT);
      for (int i = gtid; i < 32 * D; i += NT_) { const int e = i >> 11, k = i & 2047; const float w = wr[(size_t)k * 32 + e]; const bf16_t hi = f2bf(w); WRT[i] = hi; WRT[32 * D + i] = f2bf(w - bf2f(hi)); } }
    {
        LAS float* cs = (LAS float*)(F.lds);
        LAS float* red = (LAS float*)(F.lds + 16384);
        const float* c = a.in[1]; const float* w = a.in[2]; const float* bias = a.in[3]; float* ada = (float*)(ws + WS_ADA);
        bool have = false;
        for (int item = F.vcu; item < 192; item += F.G) {
            if (!have) { for (int i = F.tid; i < 4096; i += 512) { const float v = c[i]; cs[i] = v / (1.0f + expf(-v)); } __syncthreads(); have = true; }
            const int n0 = item * 64, cl = F.tid & 15, kg = F.tid >> 4;
            f32x4 a0 = {0.f, 0.f, 0.f, 0.f}, a1 = {0.f, 0.f, 0.f, 0.f};
            for (int k0 = kg; k0 < D; k0 += 32 * 16) {
                f32x4 wv[16];
#pragma unroll
                for (int u = 0; u < 16; ++u) wv[u] = __builtin_nontemporal_load((const f32x4*)(w + (size_t)(k0 + 32 * u) * (6 * D) + n0 + cl * 4));
#pragma unroll
                for (int u = 0; u < 16; ++u) { a0 += cs[k0 + 32 * u] * wv[u]; a1 += cs[2048 + k0 + 32 * u] * wv[u]; }
            }
            LAS float* rp = red + (kg * 16 + cl) * 8;
            rp[0] = a0[0]; rp[1] = a0[1]; rp[2] = a0[2]; rp[3] = a0[3]; rp[4] = a1[0]; rp[5] = a1[1]; rp[6] = a1[2]; rp[7] = a1[3];
            __syncthreads();
            if (F.tid < 128) { const int b = F.tid >> 6, col = F.tid & 63; float s = 0.f;
                for (int g = 0; g < 32; ++g) s += red[(g * 16 + (col >> 2)) * 8 + b * 4 + (col & 3)];
                ada[b * 6 * D + n0 + col] = s + bias[n0 + col]; }
            VM_WAIT(); __syncthreads();
            if (item < 64 && F.tid == 0) { __builtin_amdgcn_fence(__ATOMIC_RELEASE, "agent"); xb_add((unsigned*)(ws + WS_CTL) + CW_ADA01, 1u); }
        }
        __syncthreads();
    }
    convert_stream(a, F, (unsigned*)(ws + WS_CTL) + CW_Q0, M_EXP + M_O + M_BR + M_BA, NMAC);
    if (F.tid == 0) { unsigned sp = 0; while (xb_ld((unsigned*)(ws + WS_CTL) + CW_ADA01) < 64u && ++sp < (1u << 22)) __builtin_amdgcn_s_sleep(2);
        __builtin_amdgcn_fence(__ATOMIC_ACQUIRE, "agent"); asm volatile("s_waitcnt vmcnt(0)" ::: "memory"); }
    __syncthreads();
    p1_norm_mod(a, F);
}

__device__ __forceinline__ void p1_norm_mod(const Args& a, const Ctx& F) {
    const float* x = a.in[0]; const float* g = a.in[4]; const float* ada = (const float*)(a.ws + WS_ADA); bf16_t* XN = (bf16_t*)(a.ws + WS_XN);
    const int gw = F.vcu * NWAVES + F.wave, NGW = F.G * NWAVES;
    float gsv[32], shv[32]; int cb = -1;
    for (int t = gw; t < T; t += NGW) {
        const int b = t / SEQ; const float* xr = x + (size_t)t * D;
        if (b != cb) { cb = b; const float* ad = ada + b * 6 * D;
#pragma unroll
            for (int j = 0; j < 4; ++j) { const int c = F.lane * 8 + 512 * j;
#pragma unroll
                for (int i = 0; i < 8; ++i) { gsv[8 * j + i] = g[c + i] * (1.0f + ad[D + c + i]); shv[8 * j + i] = ad[c + i]; } } }
        float v[32]; float ss = 0.f;
#pragma unroll
        for (int j = 0; j < 4; ++j) { const f32x4 p = *(const f32x4*)(xr + F.lane * 8 + 512 * j), q = *(const f32x4*)(xr + F.lane * 8 + 512 * j + 4);
#pragma unroll
            for (int i = 0; i < 4; ++i) { v[8 * j + i] = p[i]; v[8 * j + 4 + i] = q[i]; ss += p[i] * p[i] + q[i] * q[i]; } }
        const float rs = rsqrtf(wave_sum(ss) * (1.0f / D) + RMS_EPS);
#pragma unroll
        for (int j = 0; j < 4; ++j) { const int c = F.lane * 8 + 512 * j; float o[8];
#pragma unroll
            for (int i = 0; i < 8; ++i) o[i] = v[8 * j + i] * rs * gsv[8 * j + i] + shv[8 * j + i];
            st_bf16x8(XN + (size_t)t * D + c, o); }
    }
}

constexpr int PL_OFF = LDSCTL_OFF + 4096;
__device__ __forceinline__ void p6_post(const Args& a, const Ctx& F) {
    const float* x = a.in[0]; const bf16_t* Y = (const bf16_t*)(a.ws + WS_Y); const float* g_post = a.in[5]; const float* g_pre2 = a.in[6];
    const float* ada = (const float*)(a.ws + WS_ADA); const float* b_router = a.in[14];
    bf16_t* X1 = (bf16_t*)(a.ws + WS_XN)  ; unsigned char* H2F8 = a.ws + WS_XS; const bf16_t* WRT = (const bf16_t*)(a.ws + WS_WRT);
    int* POS = (int*)(a.ws + WS_POS); int* STOK = (int*)(a.ws + WS_STOK); float* SW = (float*)(a.ws + WS_SW); unsigned* ctl = (unsigned*)(a.ws + WS_CTL);
    LAS unsigned char* HH = F.lds; LAS unsigned char* HL = F.lds + 65536;
    LAS float* PL = (LAS float*)(F.lds + PL_OFF);
    const int RPW = T / F.G, t00 = F.vcu * RPW, lane = F.lane, g = lane >> 4, li = lane & 15;
    for (int hb = 0; hb < RPW / 16; ++hb) {
        for (int rr = F.wave; rr < 16; rr += NWAVES) {
            const int t = t00 + 16 * hb + rr, b = t / SEQ; const float* ad = ada + b * 6 * D;
            float v[32]; float ss = 0.f;
#pragma unroll
            for (int j = 0; j < 4; ++j) { const v4u u = *(const v4u*)(Y + (size_t)t * D + lane * 8 + 512 * j);
                v[8 * j] = bflo(u.x); v[8 * j + 1] = bfhi(u.x); v[8 * j + 2] = bflo(u.y); v[8 * j + 3] = bfhi(u.y); v[8 * j + 4] = bflo(u.z); v[8 * j + 5] = bfhi(u.z); v[8 * j + 6] = bflo(u.w); v[8 * j + 7] = bfhi(u.w);
#pragma unroll
                for (int i = 0; i < 8; ++i) ss += v[8 * j + i] * v[8 * j + i]; }
            const float rs = rsqrtf(wave_sum(ss) * (1.0f / D) + RMS_EPS);
            float s2 = 0.f;
#pragma unroll
            for (int j = 0; j < 4; ++j) { const int c = lane * 8 + 512 * j; const float* xr = x + (size_t)t * D + c; const f32x4 p = *(const f32x4*)xr, q = *(const f32x4*)(xr + 4);
                float o[8];
#pragma unroll
                for (int i = 0; i < 8; ++i) { const float xv = i < 4 ? p[i & 3] : q[i & 3]; o[i] = xv + ad[2 * D + c + i] * (v[8 * j + i] * rs * g_post[c + i]); v[8 * j + i] = o[i]; s2 += o[i] * o[i]; }
                __builtin_nontemporal_store(pack8(o), (v4u*)(X1 + (size_t)t * D + c)); }
            const float rs2 = rsqrtf(wave_sum(s2) * (1.0f / D) + RMS_EPS);
#pragma unroll
            for (int j = 0; j < 4; ++j) { const int c = lane * 8 + 512 * j; float o[8], lo[8];
#pragma unroll
                for (int i = 0; i < 8; ++i) o[i] = v[8 * j + i] * rs2 * g_pre2[c + i] * (1.0f + ad[4 * D + c + i]) + ad[3 * D + c + i];
                const v4u hi = pack8(o);
                lo[0] = o[0] - bflo(hi.x); lo[1] = o[1] - bfhi(hi.x); lo[2] = o[2] - bflo(hi.y); lo[3] = o[3] - bfhi(hi.y); lo[4] = o[4] - bflo(hi.z); lo[5] = o[5] - bfhi(hi.z); lo[6] = o[6] - bflo(hi.w); lo[7] = o[7] - bfhi(hi.w);
                const int off = rr * 4096 + (((lane + 64 * j) ^ rr) << 4);
                *(LAS v4u*)(HH + off) = hi; *(LAS v4u*)(HL + off) = pack8(lo); *(u32x2*)(H2F8 + (size_t)t * D + c) = pack8_fp8(o); }
        }
        __syncthreads();
        if (F.wave < 4) {
            const int kq = F.wave;
            f32x4 acc[2] = {{0.f, 0.f, 0.f, 0.f}, {0.f, 0.f, 0.f, 0.f}};
#pragma unroll 4
            for (int ks = 0; ks < 16; ++ks) {
                const int off = li * 4096 + (((kq * 64 + 4 * ks + g) ^ li) << 4);
                const bfx8 ah = *(const LAS bfx8*)(HH + off), al = *(const LAS bfx8*)(HL + off);
#pragma unroll
                for (int eb = 0; eb < 2; ++eb) { const size_t wo = (size_t)(16 * eb + li) * D + kq * 512 + 32 * ks + 8 * g;
                    const bfx8 bh = *(const bfx8*)(WRT + wo), bl = *(const bfx8*)(WRT + 32 * D + wo);
                    acc[eb] = MFMA16(ah, bh, acc[eb]); acc[eb] = MFMA16(ah, bl, acc[eb]); acc[eb] = MFMA16(al, bh, acc[eb]); }
            }
#pragma unroll
            for (int eb = 0; eb < 2; ++eb)
#pragma unroll
                for (int e = 0; e < 4; ++e) PL[(((hb & 1) * 4 + kq) * 16 + 4 * g + e) * 32 + 16 * eb + li] = acc[eb][e];
        }
        __syncthreads();
        if (!((hb & 1) || hb == RPW / 16 - 1)) continue;
      if (F.wave == 0) {
        volatile LAS unsigned* lc = (volatile LAS unsigned*)(F.lds + LDSCTL_OFF + 3072);
        const int r0 = (hb & ~1) * 16, nr = (hb + 1) * 16 - r0, r = r0 + lane; const bool act = lane < nr;
        if (lane < 32) lc[lane] = 0u;
        __builtin_amdgcn_wave_barrier();
        int idx[4] = {0, 0, 0, 0}; float wgt[4] = {0.f, 0.f, 0.f, 0.f}; unsigned lr[4] = {0u, 0u, 0u, 0u};
        if (act) {
            const int hq = (r >> 4) & 1, rr = r & 15;
            float lv[32];
#pragma unroll
            for (int e = 0; e < 32; ++e) lv[e] = ((PL[((hq * 4 + 0) * 16 + rr) * 32 + e] + PL[((hq * 4 + 1) * 16 + rr) * 32 + e]) + (PL[((hq * 4 + 2) * 16 + rr) * 32 + e] + PL[((hq * 4 + 3) * 16 + rr) * 32 + e])) + b_router[e];
            float val[4];
#pragma unroll
            for (int k = 0; k < 4; ++k) { float bv = -3.0e38f; int bi = 0;
#pragma unroll
                for (int e = 0; e < 32; ++e) { const bool gt = lv[e] > bv; bv = gt ? lv[e] : bv; bi = gt ? e : bi; }
#pragma unroll
                for (int e = 0; e < 32; ++e) lv[e] = (e == bi) ? -3.0e38f : lv[e];
                idx[k] = bi; val[k] = bv; }
            float den = 0.f;
#pragma unroll
            for (int k = 0; k < 4; ++k) { wgt[k] = expf(val[k] - val[0]); den += wgt[k]; }
#pragma unroll
            for (int k = 0; k < 4; ++k) { wgt[k] /= den; lr[k] = __hip_atomic_fetch_add((LAS unsigned*)lc + idx[k], 1u, __ATOMIC_RELAXED, __HIP_MEMORY_SCOPE_WORKGROUP); }
        }
        __builtin_amdgcn_wave_barrier();
        if (lane < 32) { const unsigned c = lc[lane]; lc[32 + lane] = c ? xb_add(&ctl[CW_CNT + 64 * lane], c) : 0u; }
        __builtin_amdgcn_wave_barrier();
        if (act) { const int t = t00 + r;
#pragma unroll
            for (int k = 0; k < 4; ++k) { const int sl = idx[k] * 8192 + (int)(lc[32 + idx[k]] + lr[k]); POS[t * 4 + k] = sl; STOK[sl] = t; SW[sl] = wgt[k]; } }
      }
      __syncthreads();
    }
}

__device__ __forceinline__ void build_rt(const Args& a, const Ctx& F) {
    LAS int* rt = (LAS int*)(F.lds + RT_OFF);
    if (F.tid < 64) { unsigned* ctl = (unsigned*)(a.ws + WS_CTL); const int e = F.tid;
        const int cnt = e < 32 ? (int)xb_ld(&ctl[CW_CNT + 64 * e]) : 0, tiles = (cnt + 255) >> 8;
        int incl = tiles;
#pragma unroll
        for (int o = 1; o < 32; o <<= 1) { const int v = __shfl_up(incl, o); incl += (e >= o) ? v : 0; }
        if (e < 32) { rt[e] = incl - tiles; rt[40 + e] = cnt; }
        if (e == 31) rt[32] = incl; }
    __syncthreads();
}
__device__ __forceinline__ void build_units(const Ctx& F, int nct) {
    const LAS int* rt = (const LAS int*)(F.lds + RT_OFF); LAS int* ul = (LAS int*)(F.lds + UL_OFF);
    const int total = nct * rt[32];
    if (F.tid < 96) { const int n = F.tid, L = F.vcu + n * F.G;
        if (L < total) { int e = 0; while (e < 31 && nct * rt[e + 1] <= L) ++e;
            const int l = L - nct * rt[e], nrt = rt[e + 1] - rt[e], ct = l / nrt, r = l % nrt;
            const int valid = rt[40 + e] - 256 * r;
            ul[4 + 4 * n] = rt[e] + r; ul[4 + 4 * n + 1] = ct; ul[4 + 4 * n + 2] = e * nct + ct; ul[4 + 4 * n + 3] = e | (valid <= 128 ? 256 : 0) | (r << 12); }
        if (n == 0) { const int cnt = total > F.vcu ? (total - F.vcu + F.G - 1) / F.G : 0; ul[0] = cnt < 96 ? cnt : 96; } }
    __syncthreads();
}
__device__ __forceinline__ void p11_final(const Args& a, const Ctx& F) {
    const bf16_t* X1 = (const bf16_t*)(a.ws + WS_XN); const bf16_t* YB = (const bf16_t*)(a.ws + WS_YB); const int* POS = (const int*)(a.ws + WS_POS); const float* g = a.in[7];
    const float* ada = (const float*)(a.ws + WS_ADA); float* out = a.out;
    build_rt(a, F); const LAS int* rt = (const LAS int*)(F.lds + RT_OFF);
    const int gw = F.vcu * NWAVES + F.wave, NGW = F.G * NWAVES;
    for (int t = gw; t < T; t += NGW) {
        const int b = t / SEQ; const float* ad = ada + b * 6 * D + 5 * D;
        float y[32];
#pragma unroll
        for (int i = 0; i < 32; ++i) y[i] = 0.f;
#pragma unroll
        for (int k = 0; k < 4; ++k) { const int sl = POS[t * 4 + k]; const int r = rt[sl >> 13] * 256 + (sl & 8191);
#pragma unroll
            for (int j = 0; j < 4; ++j) { const v4u u = *(const v4u*)(YB + (size_t)r * D + F.lane * 8 + 512 * j);
                y[8 * j] += bflo(u.x); y[8 * j + 1] += bfhi(u.x); y[8 * j + 2] += bflo(u.y); y[8 * j + 3] += bfhi(u.y); y[8 * j + 4] += bflo(u.z); y[8 * j + 5] += bfhi(u.z); y[8 * j + 6] += bflo(u.w); y[8 * j + 7] += bfhi(u.w); } }
        float ss = 0.f;
#pragma unroll
        for (int i = 0; i < 32; ++i) ss += y[i] * y[i];
        const float rs = rsqrtf(wave_sum(ss) * (1.0f / D) + RMS_EPS);
#pragma unroll
        for (int j = 0; j < 4; ++j) { const int c = F.lane * 8 + 512 * j; const v4u xu = *(const v4u*)(X1 + (size_t)t * D + c); const float xv[8] = {bflo(xu.x), bfhi(xu.x), bflo(xu.y), bfhi(xu.y), bflo(xu.z), bfhi(xu.z), bflo(xu.w), bfhi(xu.w)}; float o[8];
#pragma unroll
            for (int i = 0; i < 8; ++i) o[i] = xv[i] + ad[c + i] * (y[8 * j + i] * rs * g[c + i]);
            st_f32x8_nt(out + (size_t)t * D + c, o); }
    }
}


typedef short s16x4 __attribute__((ext_vector_type(4)));
typedef short v4i16_t __attribute__((ext_vector_type(4)));
__device__ __forceinline__ s16x4 lds_tr(const LAS unsigned char* p) { return __builtin_bit_cast(s16x4, __builtin_amdgcn_ds_read_tr16_b64_v4i16((LAS v4i16_t*)p)); }
__device__ __forceinline__ bfx8 cat4(s16x4 a, s16x4 b) { return (bfx8){a[0], a[1], a[2], a[3], b[0], b[1], b[2], b[3]}; }
__device__ __forceinline__ bfx8 pack8f(const float (&x)[8]) { const v4u w = pack8(x); return __builtin_bit_cast(bfx8, w); }
constexpr int TP = 288;
constexpr int BP = 132;
constexpr size_t WS_ST = (size_t)3072 * MiB;
constexpr size_t WS_DEC = WS_ST + 64 * MiB;

__device__ __forceinline__ void p3_passA(const Args& a, const Ctx& F) {
    LAS unsigned char* VT = F.lds; LAS unsigned char* KF = F.lds + 18432; LAS unsigned char* KB = F.lds + 36864; LAS float* TOT = (LAS float*)(F.lds + 55296); LAS unsigned char* SLF = F.lds + 65536;
    const bf16_t* VR = (const bf16_t*)(a.ws + WS_VR); bf16_t* ST = (bf16_t*)(a.ws + WS_ST); float* DEC = (float*)(a.ws + WS_DEC);
    const int tid = F.tid, lane = F.lane, g = lane >> 4, q = (lane & 15) >> 2, p = lane & 3;
    v4u pv[2], pf[2], pb[2];
    auto fetchA = [&](int unit) {
        const int b = unit >> 9, h = (unit >> 6) & 7, c = unit & 63, row0 = b * SEQ + c * 64;
        { const int r = tid >> 3, sg = tid & 7; const bf16_t* src = VR + (size_t)(row0 + r) * 1024 + h * 128 + sg * 16; pv[0] = *(const v4u*)src; pv[1] = *(const v4u*)(src + 8); }
#pragma unroll
        for (int i = 0; i < 2; ++i) { const int idx = tid + 512 * i, row = idx >> 4, ch = idx & 15; const size_t go = (size_t)(row0 + row) * 1024 + h * 128 + ch * 8;
            pf[i] = *(const v4u*)((const _Float16*)(a.ws + WS_LFF) + go); pb[i] = *(const v4u*)((const _Float16*)(a.ws + WS_LFB) + go); }
    };
    if (F.vcu < 1024) fetchA(F.vcu);
    for (int unit = F.vcu; unit < 1024; unit += F.G) {
        const int b = unit >> 9, h = (unit >> 6) & 7, c = unit & 63, row0 = b * SEQ + c * 64;
        { const int r = tid >> 3, sg = tid & 7; *(LAS v4u*)(VT + r * TP + sg * 32) = pv[0]; *(LAS v4u*)(VT + r * TP + sg * 32 + 16) = pv[1]; }
#pragma unroll
        for (int i = 0; i < 2; ++i) { const int idx = tid + 512 * i, row = idx >> 4, ch = idx & 15;
            *(LAS v4u*)(SLF + (row * 128 + ch * 8) * 2) = pf[i]; *(LAS v4u*)(SLF + 16384 + (row * 128 + ch * 8) * 2) = pb[i]; }
        __syncthreads();
        if (unit + F.G < 1024) fetchA(unit + F.G);
        const int dir = tid >> 8, half = (tid >> 7) & 1, d = tid & 127;
        const LAS _Float16* LF = (const LAS _Float16*)(SLF + dir * 16384) + (half * 32) * 128 + d;
        float lf[32]; float s = 0.f;
#pragma unroll
        for (int j = 0; j < 32; ++j) { lf[j] = (float)LF[j * 128]; s += lf[j]; }
        TOT[(dir * 2 + half) * 128 + d] = s;
        __syncthreads();
        const float other = TOT[(dir * 2 + (half ^ 1)) * 128 + d];
        if (dir == 0) { float suf = half == 0 ? other : 0.f;
#pragma unroll
            for (int j = 31; j >= 0; --j) { const float kt = (1.0f - __expf(lf[j])) * __expf(suf); *(LAS bf16_t*)(KF + (half * 32 + j) * TP + d * 2) = f2bf(kt); suf += lf[j]; } }
        else { float pre = half == 1 ? other : 0.f;
#pragma unroll
            for (int j = 0; j < 32; ++j) { const float kt = (1.0f - __expf(lf[j])) * __expf(pre); *(LAS bf16_t*)(KB + (half * 32 + j) * TP + d * 2) = f2bf(kt); pre += lf[j]; } }
        const int chain_t = (b * 8 + h) * 2 + dir;
        if (half == 0) DEC[(size_t)(chain_t * 64 + c) * 128 + d] = __expf(s + other);
        __syncthreads();
        const int wdir = F.wave >> 2, db0 = (F.wave & 3) * 2; const LAS unsigned char* KT = wdir ? KB : KF;
        const int chain_w = (b * 8 + h) * 2 + wdir; bf16_t* dst = ST + (size_t)(chain_w * 64 + c) * 16384;
        bfx8 af[2][2];
#pragma unroll
        for (int dbi = 0; dbi < 2; ++dbi)
#pragma unroll
            for (int kk = 0; kk < 2; ++kk) { const LAS unsigned char* ap = KT + (32 * kk + 8 * g + q) * TP + (16 * (db0 + dbi) + 4 * p) * 2; af[dbi][kk] = cat4(lds_tr(ap), lds_tr(ap + 4 * TP)); }
#pragma unroll
        for (int vb = 0; vb < 8; ++vb) {
            bfx8 bf_[2];
#pragma unroll
            for (int kk = 0; kk < 2; ++kk) { const LAS unsigned char* bp = VT + (32 * kk + 8 * g + q) * TP + (16 * vb + 4 * p) * 2; bf_[kk] = cat4(lds_tr(bp), lds_tr(bp + 4 * TP)); }
#pragma unroll
            for (int dbi = 0; dbi < 2; ++dbi) { f32x4 acc = {0.f, 0.f, 0.f, 0.f};
                acc = MFMA16(af[dbi][0], bf_[0], acc); acc = MFMA16(af[dbi][1], bf_[1], acc);
                uint2 w; w.x = pk2(acc[0], acc[1]); w.y = pk2(acc[2], acc[3]);
                *(uint2*)(dst + (size_t)(16 * vb + (lane & 15)) * 128 + 16 * (db0 + dbi) + 4 * g) = w; }
        }
        __syncthreads();
    }
}
__device__ __forceinline__ void p3_passB(const Args& a, const Ctx& F) {
    bf16_t* ST = (bf16_t*)(a.ws + WS_ST); const float* DEC = (const float*)(a.ws + WS_DEC);
    const int per = ((32 * 2048 + F.G - 1) / F.G + 63) & ~63;
    for (int k = F.tid; k < per; k += NWAVES * 64) {
        const int gid = F.vcu * per + k; if (gid >= 32 * 2048) break;
        const int chain = gid >> 11, rem = gid & 2047, d8 = rem & 15, dir = chain & 1;
        float S[8] = {0.f, 0.f, 0.f, 0.f, 0.f, 0.f, 0.f, 0.f};
        for (int s0 = 0; s0 < 64; s0 += 8) {
            v4u x[8]; f32x4 dc[8][2];
#pragma unroll
            for (int u = 0; u < 8; ++u) { const int n = dir ? 63 - (s0 + u) : s0 + u; x[u] = *(const v4u*)(ST + (size_t)(chain * 64 + n) * 16384 + rem * 8);
                const float* dp = DEC + (size_t)(chain * 64 + n) * 128 + d8 * 8; dc[u][0] = *(const f32x4*)dp; dc[u][1] = *(const f32x4*)(dp + 4); }
#pragma unroll
            for (int u = 0; u < 8; ++u) { const int n = dir ? 63 - (s0 + u) : s0 + u;
                *(v4u*)(ST + (size_t)(chain * 64 + n) * 16384 + rem * 8) = pack8(S);
                S[0] = dc[u][0][0] * S[0] + bflo(x[u].x); S[1] = dc[u][0][1] * S[1] + bfhi(x[u].x); S[2] = dc[u][0][2] * S[2] + bflo(x[u].y); S[3] = dc[u][0][3] * S[3] + bfhi(x[u].y);
                S[4] = dc[u][1][0] * S[4] + bflo(x[u].z); S[5] = dc[u][1][1] * S[5] + bfhi(x[u].z); S[6] = dc[u][1][2] * S[6] + bflo(x[u].w); S[7] = dc[u][1][3] * S[7] + bfhi(x[u].w); }
        }
    }
}
__device__ __forceinline__ void p3_passC(const Args& a, const Ctx& F) {
    LAS unsigned char* VT = F.lds; LAS unsigned char* QE = F.lds + 18432; LAS unsigned char* K0 = F.lds + 3 * 18432;
    LAS float* DJ = (LAS float*)(F.lds + 5 * 18432); LAS float* OX = DJ + 1024;
    LAS unsigned char* SLF = (LAS unsigned char*)OX; LAS unsigned char* SQ = F.lds + LDSCTL_OFF + 4096;
    static_assert(4 * 16 * BP * 4 >= 32768 && LDSCTL_OFF + 4096 + 16384 <= LDS_BYTES, "pass C staging");
    static_assert(5 * 18432 + 4096 + 4 * 16 * BP * 4 <= RING_BYTES, "pass C LDS map");
    const bf16_t* QR = (const bf16_t*)(a.ws + WS_QR); const bf16_t* VR = (const bf16_t*)(a.ws + WS_VR); const bf16_t* ST = (const bf16_t*)(a.ws + WS_ST);
    const bf16_t* GO = (const bf16_t*)(a.ws + WS_GO); const float* g_out = a.in[9]; bf16_t* OREC = (bf16_t*)(a.ws + WS_OREC);
    const int tid = F.tid, lane = F.lane, g = lane >> 4, li = lane & 15, q = li >> 2, p = lane & 3;
    v4u cv[2], cf[2], cb[2], cq[2];
    auto fetchC = [&](int unit) {
        const int b = unit >> 9, h = (unit >> 6) & 7, c = unit & 63, row0 = b * SEQ + c * 64;
        { const int r = tid >> 3, sg = tid & 7; const size_t so = (size_t)(row0 + r) * 1024 + h * 128 + sg * 16; cv[0] = *(const v4u*)(VR + so); cv[1] = *(const v4u*)(VR + so + 8); }
#pragma unroll
        for (int i = 0; i < 2; ++i) { const int idx = tid + 512 * i, row = idx >> 4, ch = idx & 15; const size_t go = (size_t)(row0 + row) * 1024 + h * 128 + ch * 8;
            cf[i] = *(const v4u*)((const _Float16*)(a.ws + WS_LFF) + go); cb[i] = *(const v4u*)((const _Float16*)(a.ws + WS_LFB) + go); cq[i] = *(const v4u*)(QR + go); }
    };
    if (F.vcu < 1024) fetchC(F.vcu);
    for (int unit = F.vcu; unit < 1024; unit += F.G) {
        const int b = unit >> 9, h = (unit >> 6) & 7, c = unit & 63, row0 = b * SEQ + c * 64;
        { const int r = tid >> 3, sg = tid & 7; *(LAS v4u*)(VT + r * TP + sg * 32) = cv[0]; *(LAS v4u*)(VT + r * TP + sg * 32 + 16) = cv[1]; }
#pragma unroll
        for (int i = 0; i < 2; ++i) { const int idx = tid + 512 * i, row = idx >> 4, ch = idx & 15; const int lo_ = (row * 128 + ch * 8) * 2;
            *(LAS v4u*)(SLF + lo_) = cf[i]; *(LAS v4u*)(SLF + 16384 + lo_) = cb[i]; *(LAS v4u*)(SQ + lo_) = cq[i]; }
        __syncthreads();
        {
            const int dir = tid >> 8, half = (tid >> 7) & 1, d = tid & 127;
            const LAS _Float16* LF = (const LAS _Float16*)(SLF + dir * 16384) + (half * 32) * 128 + d;
            const LAS bf16_t* Qp = (const LAS bf16_t*)SQ + (half * 32) * 128 + d;
            float lf[32], qv[32];
#pragma unroll
            for (int j = 0; j < 32; ++j) { lf[j] = (float)LF[j * 128]; qv[j] = bf2f(Qp[j * 128]); }
            LAS unsigned char* QEd = QE + dir * 18432; LAS unsigned char* K0d = K0 + dir * 18432;
#pragma unroll
            for (int bb = 0; bb < 2; ++bb) {
                float run = 0.f;
                if (dir == 0) {
#pragma unroll
                    for (int jj = 0; jj < 16; ++jj) { const int j = 16 * bb + jj; run += lf[j]; const float e = __expf(run);
                        *(LAS bf16_t*)(QEd + (half * 32 + j) * TP + d * 2) = f2bf(qv[j] * e);
                        *(LAS bf16_t*)(K0d + (half * 32 + j) * TP + d * 2) = f2bf((1.0f - __expf(lf[j])) * __expf(fminf(-run, 60.0f))); }
                } else {
#pragma unroll
                    for (int jj = 15; jj >= 0; --jj) { const int j = 16 * bb + jj; run += lf[j]; const float e = __expf(run);
                        *(LAS bf16_t*)(QEd + (half * 32 + j) * TP + d * 2) = f2bf(qv[j] * e);
                        *(LAS bf16_t*)(K0d + (half * 32 + j) * TP + d * 2) = f2bf((1.0f - __expf(lf[j])) * __expf(fminf(-run, 60.0f))); }
                }
                DJ[(dir * 4 + half * 2 + bb) * 128 + d] = __expf(run);
            }
        }
        __syncthreads();
        if (unit + F.G < 1024) fetchC(unit + F.G);
        const int I = F.wave & 3, wdir = F.wave >> 2;
        const LAS unsigned char* QEd = QE + wdir * 18432; const LAS unsigned char* K0d = K0 + wdir * 18432; const LAS float* DJd = DJ + wdir * 512;
        const int chain = (b * 8 + h) * 2 + wdir; const bf16_t* Sp = ST + (size_t)(chain * 64 + c) * 16384;
        bfx8 sf0[8];
#pragma unroll
        for (int vb = 0; vb < 8; ++vb) sf0[vb] = *(const bfx8*)(Sp + (size_t)(16 * vb + li) * 128 + 8 * g);
        float qf[4][8];
#pragma unroll
        for (int ks = 0; ks < 4; ++ks) { const bfx8 x = *(const LAS bfx8*)(QEd + (16 * I + li) * TP + (32 * ks + 8 * g) * 2);
#pragma unroll
            for (int j = 0; j < 8; ++j) qf[ks][j] = bf2f((bf16_t)x[j]); }
        f32x4 pt[4], o[8];
#pragma unroll
        for (int j = 0; j < 4; ++j) pt[j] = (f32x4){0.f, 0.f, 0.f, 0.f};
#pragma unroll
        for (int j = 0; j < 8; ++j) o[j] = (f32x4){0.f, 0.f, 0.f, 0.f};
#pragma unroll
        for (int step = 0; step < 4; ++step) {
            const int J = wdir ? I + step : I - step;
            if (J >= 0 && J < 4) {
                if (step > 0) {
                    const int Jd = J;
#pragma unroll
                    for (int ks = 0; ks < 4; ++ks) {
#pragma unroll
                        for (int hh = 0; hh < 2; ++hh) { const f32x4 dv = *(const LAS f32x4*)(DJd + Jd * 128 + 32 * ks + 8 * g + 4 * hh);
#pragma unroll
                            for (int j = 0; j < 4; ++j) qf[ks][4 * hh + j] *= dv[j]; } }
                }
                f32x4 acc = {0.f, 0.f, 0.f, 0.f};
#pragma unroll
                for (int ks = 0; ks < 4; ++ks) acc = MFMA16(*(const LAS bfx8*)(K0d + (16 * J + li) * TP + (32 * ks + 8 * g) * 2), pack8f(qf[ks]), acc);
                if (step == 0) {
#pragma unroll
                    for (int e = 0; e < 4; ++e) { const int jj = 4 * g + e; const bool keep = wdir ? (jj >= li) : (jj <= li); acc[e] = keep ? acc[e] : 0.f; } }
                pt[J] = acc;
            }
        }
#pragma unroll
        for (int ks = 0; ks < 4; ++ks) { const bfx8 qa = pack8f(qf[ks]);
#pragma unroll
            for (int vb = 0; vb < 8; ++vb) { const bfx8 sf = ks == 0 ? sf0[vb] : *(const bfx8*)(Sp + (size_t)(16 * vb + li) * 128 + 32 * ks + 8 * g); o[vb] = MFMA16(qa, sf, o[vb]); } }
#pragma unroll
        for (int kk = 0; kk < 2; ++kk) {
            float pe[8];
#pragma unroll
            for (int e = 0; e < 4; ++e) { pe[e] = pt[2 * kk][e]; pe[4 + e] = pt[2 * kk + 1][e]; }
            const bfx8 pa = pack8f(pe);
#pragma unroll
            for (int vb = 0; vb < 8; ++vb) { const LAS unsigned char* bp = VT + (32 * kk + 4 * g + q) * TP + (16 * vb + 4 * p) * 2;
                o[vb] = MFMA16(pa, cat4(lds_tr(bp), lds_tr(bp + 16 * TP)), o[vb]); }
        }
        v4u gov[2];
#pragma unroll
        for (int i = 0; i < 2; ++i) { const int idx = tid + 512 * i; gov[i] = *(const v4u*)(GO + (size_t)(row0 + (idx >> 4)) * 1024 + h * 128 + (idx & 15) * 8); }
        if (wdir == 1) {
#pragma unroll
            for (int vb = 0; vb < 8; ++vb)
#pragma unroll
                for (int e = 0; e < 4; ++e) OX[(I * 16 + 4 * g + e) * BP + 16 * vb + li] = o[vb][e]; }
        __syncthreads();
        if (wdir == 0) {
            float ssq[4];
#pragma unroll
            for (int e = 0; e < 4; ++e) { float sacc = 0.f;
#pragma unroll
                for (int vb = 0; vb < 8; ++vb) { o[vb][e] += OX[(I * 16 + 4 * g + e) * BP + 16 * vb + li]; sacc += o[vb][e] * o[vb][e]; }
                sacc += __shfl_xor(sacc, 1); sacc += __shfl_xor(sacc, 2); sacc += __shfl_xor(sacc, 4); sacc += __shfl_xor(sacc, 8); ssq[e] = sacc; }
#pragma unroll
            for (int e = 0; e < 4; ++e) { const float rs = rsqrtf(ssq[e] * (1.0f / 128.0f) + RMS_EPS);
#pragma unroll
                for (int vb = 0; vb < 8; ++vb) OX[(I * 16 + 4 * g + e) * BP + 16 * vb + li] = o[vb][e] * rs; }
        }
        __syncthreads();
#pragma unroll
        for (int i = 0; i < 2; ++i) {
            const int idx = tid + 512 * i, rl = idx >> 4, c8 = (idx & 15) * 8;
            const f32x4 a0 = *(const LAS f32x4*)(OX + rl * BP + c8), a1 = *(const LAS f32x4*)(OX + rl * BP + c8 + 4);
            const f32x4 w0 = *(const f32x4*)(g_out + h * 128 + c8), w1 = *(const f32x4*)(g_out + h * 128 + c8 + 4);
            const v4u gu = gov[i];
            float x[8] = {a0[0] * w0[0] * bflo(gu.x), a0[1] * w0[1] * bfhi(gu.x), a0[2] * w0[2] * bflo(gu.y), a0[3] * w0[3] * bfhi(gu.y), a1[0] * w1[0] * bflo(gu.z), a1[1] * w1[1] * bfhi(gu.z), a1[2] * w1[2] * bflo(gu.w), a1[3] * w1[3] * bfhi(gu.w)};
            st_bf16x8(OREC + (size_t)(row0 + rl) * 1024 + h * 128 + c8, x);
        }
        __syncthreads();
    }
}
constexpr size_t WS_ATP = WS_DEC + 2 * MiB;
constexpr size_t WS_ATM = WS_ATP + 24 * MiB;
constexpr size_t WS_ATL = WS_ATM + 1 * MiB;
__device__ __forceinline__ void p3_attn(const Args& a, const Ctx& F) {
    LAS unsigned char* KT = F.lds; LAS unsigned char* VT = F.lds + 55296; LAS float* TB = (LAS float*)(F.lds + 55296 + 59904);
    const bf16_t* QA = (const bf16_t*)(a.ws + WS_QA); const bf16_t* KA = (const bf16_t*)(a.ws + WS_KA); const bf16_t* VA = (const bf16_t*)(a.ws + WS_VA);
    bf16_t* ATP = (bf16_t*)(a.ws + WS_ATP); float* ATM = (float*)(a.ws + WS_ATM); float* ATL = (float*)(a.ws + WS_ATL); const float* rel_bias = a.in[20];
    const int tid = F.tid, lane = F.lane, g = lane >> 4, li = lane & 15, q = li >> 2, p = lane & 3;
    v4u kx[6], vx[6]; bfx8 qn[4]; float tbv = 0.f;
    auto fetch = [&](int unit) {
        const int bh = unit >> 6, b = bh / 12, head = bh % 12, grp = head >> 2, dil = grp == 0 ? 1 : (grp == 1 ? 4 : 16);
        const int nqb = 64 / dil, u6 = unit & 63, r = u6 / nqb, qb = u6 % nqb, l0 = qb * 64, L = SEQ / dil;
        if (tid < 129) tbv = rel_bias[t5_bucket((tid - 64) * dil) * 12 + head];
#pragma unroll
        for (int it = 0; it < 6; ++it) { const int idx = tid + 512 * it, row = idx >> 4, ch = idx & 15, kl = l0 - 64 + row;
            kx[it] = (v4u){0u, 0u, 0u, 0u}; vx[it] = (v4u){0u, 0u, 0u, 0u};
            if (kl >= 0 && kl < L) { const size_t o = ((size_t)b * SEQ + (size_t)kl * dil + r) * DATT + head * 128 + ch * 8; kx[it] = *(const v4u*)(KA + o); vx[it] = *(const v4u*)(VA + o); } }
        const size_t tq = (size_t)b * SEQ + (size_t)(l0 + 16 * (F.wave & 3) + li) * dil + r;
#pragma unroll
        for (int ks = 0; ks < 4; ++ks) qn[ks] = *(const bfx8*)(QA + tq * DATT + head * 128 + 32 * ks + 8 * g);
    };
    if (F.vcu < 1536) fetch(F.vcu);
    for (int unit = F.vcu; unit < 1536; unit += F.G) {
        const int bh = unit >> 6, b = bh / 12, head = bh % 12, grp = head >> 2, slot = head & 3, dil = grp == 0 ? 1 : (grp == 1 ? 4 : 16);
        const int nqb = 64 / dil, u6 = unit & 63, r = u6 / nqb, qb = u6 % nqb, l0 = qb * 64, L = SEQ / dil;
        if (tid < 129) TB[tid] = tbv;
#pragma unroll
        for (int it = 0; it < 6; ++it) { const int idx = tid + 512 * it, row = idx >> 4, ch = idx & 15;
            *(LAS v4u*)(KT + row * TP + ch * 16) = kx[it]; *(LAS v4u*)(VT + row * TP + ch * 16) = vx[it]; }
        if (tid < 256) *(LAS v4u*)(VT + (192 + (tid >> 4)) * TP + (tid & 15) * 16) = (v4u){0u, 0u, 0u, 0u};
        __syncthreads();
        const int I = F.wave & 3, hv = F.wave >> 2;
        const size_t tokq = (size_t)b * SEQ + (size_t)(l0 + 16 * I + li) * dil + r;
        bfx8 qf[4];
#pragma unroll
        for (int ks = 0; ks < 4; ++ks) qf[ks] = qn[ks];
        if (unit + F.G < 1536) fetch(unit + F.G);
        f32x4 s[9]; float m = -1e30f;
#pragma unroll
        for (int Jr = 0; Jr < 9; ++Jr) {
            const int J = I + Jr; f32x4 acc = {0.f, 0.f, 0.f, 0.f};
#pragma unroll
            for (int ks = 0; ks < 4; ++ks) acc = MFMA16(*(const LAS bfx8*)(KT + (16 * J + li) * TP + (32 * ks + 8 * g) * 2), qf[ks], acc);
#pragma unroll
            for (int e = 0; e < 4; ++e) { const int rel = 16 * Jr + 4 * g + e - 64 - li, kl = l0 - 64 + 16 * J + 4 * g + e;
                const bool valid = rel >= -64 && rel <= 64 && kl >= 0 && kl < L;
                const int ti = rel + 64 < 0 ? 0 : (rel + 64 > 128 ? 128 : rel + 64);
                acc[e] = valid ? acc[e] + TB[ti] : -1e30f; m = fmaxf(m, acc[e]); }
            s[Jr] = acc;
        }
        m = fmaxf(m, __shfl_xor(m, 16)); m = fmaxf(m, __shfl_xor(m, 32));
        float lsum = 0.f;
#pragma unroll
        for (int Jr = 0; Jr < 9; ++Jr)
#pragma unroll
            for (int e = 0; e < 4; ++e) { const float pv = __expf(s[Jr][e] - m); s[Jr][e] = pv; lsum += pv; }
        lsum += __shfl_xor(lsum, 16); lsum += __shfl_xor(lsum, 32);
        f32x4 o[4];
#pragma unroll
        for (int vb = 0; vb < 4; ++vb) o[vb] = (f32x4){0.f, 0.f, 0.f, 0.f};
#pragma unroll
        for (int kk = 0; kk < 5; ++kk) {
            float pe[8];
#pragma unroll
            for (int e = 0; e < 4; ++e) { pe[e] = s[2 * kk][e]; pe[4 + e] = (2 * kk + 1 < 9) ? s[(2 * kk + 1 < 9) ? 2 * kk + 1 : 8][e] : 0.f; }
            const bfx8 pa = pack8f(pe);
#pragma unroll
            for (int vb = 0; vb < 4; ++vb) { const LAS unsigned char* bp = VT + (16 * (I + 2 * kk) + 4 * g + q) * TP + (64 * hv + 16 * vb + 4 * p) * 2;
                o[vb] = MFMA16(pa, cat4(lds_tr(bp), lds_tr(bp + 16 * TP)), o[vb]); }
        }
#pragma unroll
        for (int e = 0; e < 4; ++e) { const float lr = __shfl(lsum, 4 * g + e); const float inv = 1.0f / lr;
            const size_t tok = (size_t)b * SEQ + (size_t)(l0 + 16 * I + 4 * g + e) * dil + r;
#pragma unroll
            for (int vb = 0; vb < 4; ++vb) ATP[((size_t)grp * T + tok) * 512 + slot * 128 + 64 * hv + 16 * vb + li] = f2bf(o[vb][e] * inv); }
        if (g == 0 && hv == 0) { ATM[((size_t)grp * T + tokq) * 4 + slot] = m; ATL[((size_t)grp * T + tokq) * 4 + slot] = lsum; }
        __syncthreads();
    }
}
__device__ __forceinline__ void p3_attn_combine(const Args& a, const Ctx& F) {
    const bf16_t* ATP = (const bf16_t*)(a.ws + WS_ATP); const float* ATM = (const float*)(a.ws + WS_ATM); const float* ATL = (const float*)(a.ws + WS_ATL); bf16_t* OATT = (bf16_t*)(a.ws + WS_OATT);
    const int gw = F.vcu * NWAVES + F.wave, NGW = F.G * NWAVES, lane = F.lane, slot = lane >> 4;
    for (int t = gw; t < T; t += NGW) {
        float mg[3], lg[3];
#pragma unroll
        for (int gi = 0; gi < 3; ++gi) { mg[gi] = ATM[((size_t)gi * T + t) * 4 + slot]; lg[gi] = ATL[((size_t)gi * T + t) * 4 + slot]; }
        const float mx = fmaxf(mg[0], fmaxf(mg[1], mg[2])); float w[3], den = 0.f;
#pragma unroll
        for (int gi = 0; gi < 3; ++gi) { w[gi] = __expf(mg[gi] - mx) * lg[gi]; den += w[gi]; }
        float acc[8] = {0.f, 0.f, 0.f, 0.f, 0.f, 0.f, 0.f, 0.f};
#pragma unroll
        for (int gi = 0; gi < 3; ++gi) { const v4u x = *(const v4u*)(ATP + ((size_t)gi * T + t) * 512 + lane * 8); const float wn = w[gi] / den;
            acc[0] += wn * bflo(x.x); acc[1] += wn * bfhi(x.x); acc[2] += wn * bflo(x.y); acc[3] += wn * bfhi(x.y); acc[4] += wn * bflo(x.z); acc[5] += wn * bfhi(x.z); acc[6] += wn * bflo(x.w); acc[7] += wn * bfhi(x.w); }
        st_bf16x8(OATT + (size_t)t * DAO + lane * 8, acc);
    }
}

__global__ void __launch_bounds__(NWAVES * 64, 2) mega_fwd(Args args) {
    extern __shared__ __attribute__((aligned(16))) unsigned char lds[];
    Ctx F; F.lds = (LAS unsigned char*)lds; F.tid = threadIdx.x; F.lane = F.tid & 63; F.wave = __builtin_amdgcn_readfirstlane(F.tid >> 6);
    F.G = gridDim.x; { const int bx = blockIdx.x; F.vcu = (F.G % 8 == 0) ? (bx % 8) * (F.G / 8) + bx / 8 : bx; }
    unsigned char* ws = args.ws;
    for (int u = F.tid; u < (LDS_BYTES - LDSCTL_OFF) / 4; u += NWAVES * 64) ((LAS unsigned*)(F.lds + LDSCTL_OFF))[u] = 0u;
    __syncthreads();
    XcdBarrier bar = xcd_barrier_post((unsigned*)(ws + WS_CTL) + CW_BAR, (volatile LAS unsigned*)(F.lds + MISC_OFF) + 8, (unsigned)F.G);
    const int G1 = F.G - (F.G / 32) * CONV_PER_32; const bool conv = (int)blockIdx.x >= G1;
    XcdBarrier bar1 = bar;
    if (!conv) bar1 = xcd_barrier_post((unsigned*)(ws + WS_CTL) + CW_BAR + XCD_BAR_WORDS, (volatile LAS unsigned*)(F.lds + MISC_OFF) + 10, (unsigned)G1);
    const int lo = args.ph_lo, hi = args.ph_hi;
#define IN(k) (lo <= (k) && (k) < hi)
#define SEAM(k) do { if (IN(k) && IN((k) + 1)) xcd_barrier(bar); } while (0)
    unsigned char* wo = ws + (size_t)args.pad * 512 * MiB;
    ProjOut P; P.QR = (bf16_t*)(wo + WS_QR); P.VR = (bf16_t*)(wo + WS_VR); P.LFF = (float*)(wo + WS_LFF); P.LFB = (float*)(wo + WS_LFB); P.GO = (bf16_t*)(wo + WS_GO);
    P.QA = (bf16_t*)(wo + WS_QA); P.KA = (bf16_t*)(wo + WS_KA); P.VA = (bf16_t*)(wo + WS_VA); P.GR = (bf16_t*)(wo + WS_GR); P.GA = (bf16_t*)(wo + WS_GA); P.lb = (const float*)(ws + WS_LB);

    if (IN(0)) { p0_prologue(args, F); } SEAM(0);
    if (IN(1)) {
        if (!conv) {
            Ctx C = F; C.G = G1; { const int bx = blockIdx.x; C.vcu = (G1 % 8 == 0) ? (bx % 8) * (G1 / 8) + bx / 8 : bx; }
            Ctx Cr = C; Cr.vcu = G1 - 1 - C.vcu;
            {
                pg8::Gemm g{(const bf16_t*)(ws + WS_XN), (const bf16_t*)(ws + WS_WIN_T), D, nullptr}; pg8::ProjOrder S; S.init(T, DIN, G1, (int)blockIdx.x);
                EpiProjT E{P}; pg8::gemm_phase<EpiProjT, pg8::ProjOrder, true, true>(F.lds, g, S, E);
            }
            xcd_barrier(bar1);
            p3_attn(args, C); p3_passA(args, Cr); xcd_barrier(bar1); p3_passB(args, C); p3_attn_combine(args, C); xcd_barrier(bar1); p3_passC(args, C);
        }
        convert_stream(args, F, (unsigned*)(ws + WS_CTL) + CW_Q3, M_EXP, M_EXP + M_O + M_BR + M_BA);
        convert_stream<true>(args, F, (unsigned*)(ws + WS_CTL) + CW_Q1, 0, M_GU);
    }
    SEAM(3);
    if (IN(4)) {
        { pg8::Gemm g{(const bf16_t*)(ws + WS_OREC), (const bf16_t*)(ws + WS_WBR_T), DREC, nullptr}; pg8::StaticOrder S; S.init(T, D, F.G, (int)blockIdx.x);
          EpiBf16T E{(bf16_t*)(ws + WS_YR), D}; pg8::gemm_phase<EpiBf16T, pg8::StaticOrder, true>(F.lds, g, S, E); }
        VM_WAIT(); __syncthreads();
        { pg8::Gemm g{(const bf16_t*)(ws + WS_OATT), (const bf16_t*)(ws + WS_WBA_T), DAO, nullptr}; pg8::StaticOrder S; S.init(T, D, F.G, (int)blockIdx.x);
          EpiMergeT E{(const bf16_t*)(ws + WS_YR), P.GR, P.GA, (bf16_t*)(ws + WS_MG)}; pg8::gemm_phase<EpiMergeT, pg8::StaticOrder, true>(F.lds, g, S, E); }
    } SEAM(4);
    if (IN(5)) {
        pg8::Gemm g{(const bf16_t*)(ws + WS_MG), (const bf16_t*)(ws + WS_WO_T), D, nullptr}; pg8::StaticOrder S; S.init(T, D, F.G, (int)blockIdx.x);
        EpiBf16T E{(bf16_t*)(ws + WS_Y), D}; pg8::gemm_phase<EpiBf16T, pg8::StaticOrder, true>(F.lds, g, S, E);
    } SEAM(5);
    if (IN(6)) { p6_post(args, F); } SEAM(6);
    if (IN(9)) {
        build_rt(args, F);
        int G9 = F.G;
        if (F.G % 8 == 0 && G1 < F.G) { const int nu = 16 * ((const LAS int*)(F.lds + RT_OFF))[32], R = (nu + G1 - 1) / G1; G9 = R > 0 ? ((nu + R - 1) / R + 7) & ~7 : G1; G9 = G9 < 128 ? 128 : G9 > G1 ? G1 : G9; }
        if ((int)blockIdx.x < G9) {
            Ctx C = F; C.G = G9; { const int bx = blockIdx.x; C.vcu = (G9 % 8 == 0) ? (bx % 8) * (G9 / 8) + bx / 8 : bx; }
            build_units(C, 16);
            pg8::ListOrder S{(const LAS int*)(F.lds + UL_OFF) + 4, ((const LAS int*)(F.lds + UL_OFF))[0]};
            pg8::Gemm g{(const bf16_t*)(ws + WS_XS), (const bf16_t*)(ws + WS_WGU_T), D, (const int*)(ws + WS_STOK)};
            EpiGateUpT E{args.in[16], ws + WS_ACT}; pg8::gemm_phase<EpiGateUpT, pg8::ListOrder, true, true, true, true>(F.lds, g, S, E);
        }
        VM_WAIT(); __syncthreads();
        convert_stream<true>(args, F, (unsigned*)(ws + WS_CTL) + CW_Q2, M_GU, M_EXP);
    } SEAM(9);
    if (IN(10)) {
        build_rt(args, F); build_units(F, 8);
        pg8::ListOrder S{(const LAS int*)(F.lds + UL_OFF) + 4, ((const LAS int*)(F.lds + UL_OFF))[0]};
        pg8::Gemm g{(const bf16_t*)(ws + WS_ACT), (const bf16_t*)(ws + WS_WDN_T), DFF, nullptr};
        EpiDownT E{args.in[18], (const float*)(ws + WS_SW), (bf16_t*)(ws + WS_YB)}; pg8::gemm_phase<EpiDownT, pg8::ListOrder, true, true, false, true>(F.lds, g, S, E);
    } SEAM(10);
    if (IN(11)) { p11_final(args, F); }
#undef IN
#undef SEAM
}

static int g_grid = 0;
static void launch_mega(const Args& base, int lo, int hi, int li, hipStream_t stream) {
    Args a = base; a.ph_lo = lo; a.ph_hi = hi; a.li = li & 0xff; a.pad = li >> 8;
    hipLaunchKernelGGL(mega_fwd, dim3(g_grid), dim3(NWAVES * 64), LDS_BYTES, stream, a);
}
extern "C" void kernel_launch(void* const* d_in, const int* in_sizes, int n_in, void* d_out, int out_size, void* d_ws, size_t ws_size, hipStream_t stream) {
    if (n_in != 21 || ws_size < WS_TOP) { fprintf(stderr, "kernel_launch: unexpected inputs/workspace (%d, %zu)\n", n_in, ws_size); return; }
    if (g_grid == 0) {
        int dev = 0, cus = 0;
        if (hipGetDevice(&dev) != hipSuccess || hipDeviceGetAttribute(&cus, hipDeviceAttributeMultiprocessorCount, dev) != hipSuccess || cus <= 0) { g_grid = -1; return; }
        if (hipFuncSetAttribute((const void*)mega_fwd, hipFuncAttributeMaxDynamicSharedMemorySize, LDS_BYTES) != hipSuccess) { g_grid = -1; return; }
        int nb = 0;
        if (hipOccupancyMaxActiveBlocksPerMultiprocessor(&nb, (const void*)mega_fwd, NWAVES * 64, (size_t)LDS_BYTES) != hipSuccess || nb < 1) { g_grid = -1; return; }
        int gsel = 256; while (gsel > cus) gsel >>= 1;
        g_grid = gsel < 16 ? -1 : gsel;
    }
    if (g_grid < 0) return;
    unsigned char* ws = (unsigned char*)d_ws; float* out = (float*)d_out;
    Args base{}; for (int i = 0; i < 21; ++i) base.in[i] = (const float*)d_in[i]; base.out = out; base.ws = ws;

    (void)hipMemsetAsync(ws + WS_CTL, 0, 1 * MiB, stream);
    launch_mega(base, 0, 12, 0, stream);
}
```
